# Optimizing an MI355X kernel written in HIP

```python
import jax, jax.numpy as jnp
from jax import lax
import numpy as np

D_MODEL = 2048
BATCH = 8
SEQ = 2048
DEPTH = 4
DEC_BATCH = 8
DEC_SEQ = 16
PAST_LEN = 4096

CHUNK = 64
N_BRANCH = 4
MIX_W = 512
RWKV_HEADS = 8
RWKV_HEAD = 64
W_RANK = 96
A_RANK = 96
G_RANK = 256
GN_EPS = 64e-5
RWKV_COLS = 3 * MIX_W + W_RANK + A_RANK + G_RANK
RWKV_SPLITS = (MIX_W, 2 * MIX_W, 3 * MIX_W, 3 * MIX_W + W_RANK, 3 * MIX_W + W_RANK + A_RANK)
GMLP_CHUNK = 128
GMLP_GROUPS = 8
GMLP_GDIM = MIX_W // GMLP_GROUPS
CONV_W = 31
ATTN_HEADS = 8
ATTN_HEAD = 64
BAND_PAST_CHUNKS = 8
BAND_PAST = BAND_PAST_CHUNKS * CHUNK
REL_CLIP = 128
D_FF = ((8 * D_MODEL // 3 + 255) // 256) * 256
OFF_RWKV = 0
OFF_GMLP = OFF_RWKV + RWKV_COLS
OFF_CONV = OFF_GMLP + 2 * MIX_W
OFF_ATTN = OFF_CONV + 2 * MIX_W
OFF_GATE = OFF_ATTN + 3 * MIX_W
IN_COLS = OFF_GATE + N_BRANCH * D_MODEL

kernel_name = "hybrid_streaming_encoder_step"


def rms_norm(x, g, eps=1e-6):
    xf = x.astype(jnp.float32)
    y = xf * lax.rsqrt(jnp.mean(xf * xf, -1, keepdims=True) + eps)
    return (y * g.astype(jnp.float32)).astype(x.dtype)


def layer_norm(x, g, b, eps=1e-5):
    xf = x.astype(jnp.float32)
    mu = jnp.mean(xf, -1, keepdims=True)
    var = jnp.mean(jnp.square(xf - mu), -1, keepdims=True)
    y = (xf - mu) * lax.rsqrt(var + eps) * g.astype(jnp.float32) + b.astype(jnp.float32)
    return y.astype(x.dtype)


def wkv7_scan(S0, r, w, k, v, a, b):
    def step(S, inp):
        r_t, w_t, k_t, v_t, a_t, b_t = inp
        sa = jnp.einsum("bhvk,bhk->bhv", S, a_t)
        S = S * w_t[:, :, None, :] + sa[..., None] * b_t[:, :, None, :] + v_t[..., None] * k_t[:, :, None, :]
        return S, jnp.einsum("bhvk,bhk->bhv", S, r_t)
    xs = tuple(jnp.swapaxes(t, 0, 1) for t in (r, w, k, v, a, b))
    S, ys = lax.scan(step, S0, xs)
    return jnp.swapaxes(ys, 0, 1), S


def rwkv_mixer(p, shift_prev, S0, lw):
    B, T, _ = p.shape
    f32 = jnp.float32
    prev = jnp.concatenate([shift_prev[:, None, :].astype(p.dtype), p[:, :-1]], axis=1)
    xs = p.astype(f32) + lw["rwkv_mu"].astype(f32) * (prev.astype(f32) - p.astype(f32))
    r, k, v, wl, al, gl = jnp.split(xs, RWKV_SPLITS, axis=-1)
    log_w = -jax.nn.softplus(-(lw["rwkv_w0"].astype(f32) + jnp.tanh(wl) @ lw["rwkv_w2"].astype(f32))) - 0.5
    decay = jnp.exp(-jnp.exp(log_w))
    a = jax.nn.sigmoid(lw["rwkv_a0"].astype(f32) + al @ lw["rwkv_a2"].astype(f32))
    g = jax.nn.sigmoid(gl) @ lw["rwkv_g2"].astype(f32)
    heads = lambda t: t.reshape(B, T, RWKV_HEADS, RWKV_HEAD)
    kk = heads(k * lw["rwkv_kk"].astype(f32))
    kk = kk * lax.rsqrt(jnp.maximum(jnp.sum(kk * kk, -1, keepdims=True), 1e-24))
    k = k * (1.0 + (a - 1.0) * lw["rwkv_ka"].astype(f32))
    r_h, k_h, v_h, a_h = heads(r), heads(k), heads(v), heads(a)
    y, S = wkv7_scan(S0.astype(f32), r_h, heads(decay), k_h, v_h, -kk, kk * a_h)
    mu_y = jnp.mean(y, -1, keepdims=True)
    var_y = jnp.mean(jnp.square(y - mu_y), -1, keepdims=True)
    y = ((y - mu_y) * lax.rsqrt(var_y + GN_EPS)).reshape(B, T, MIX_W)
    y = y * lw["rwkv_gn_w"].astype(f32) + lw["rwkv_gn_b"].astype(f32)
    bonus = (jnp.sum(r_h * k_h * lw["rwkv_rk"].astype(f32), -1, keepdims=True) * v_h).reshape(B, T, MIX_W)
    o = (y + bonus) * g
    return o.astype(p.dtype), p[:, -1], S.astype(S0.dtype)


def gmlp_mixer(p, lw):
    B, T, _ = p.shape
    u = jax.nn.gelu(p[..., :MIX_W])
    v = layer_norm(jax.nn.gelu(p[..., MIX_W:]), lw["gmlp_ln_w"], lw["gmlp_ln_b"])
    L = min(T, GMLP_CHUNK)
    mask = jnp.tril(jnp.ones((L, L), dtype=bool))
    w_s = jnp.where(mask[None], lw["gmlp_ws"][:, :L, :L], 0)
    vc = v.reshape(B, T // L, L, GMLP_GROUPS, GMLP_GDIM)
    mixed = jnp.einsum("gij,bcjgd->bcigd", w_s, vc) + lw["gmlp_bs"][:, :L].T[None, None, :, :, None]
    return u * mixed.reshape(B, T, MIX_W), v


def conv_mixer(p, conv_prev, lw):
    z = p[..., :MIX_W] * jax.nn.sigmoid(p[..., MIX_W:])
    zp = jnp.concatenate([conv_prev.astype(z.dtype), z], axis=1)
    y = lax.conv_general_dilated(zp, lw["conv_dw"][:, None, :].astype(z.dtype), window_strides=(1,),
                                 padding="VALID", dimension_numbers=("NWC", "WIO", "NWC"),
                                 feature_group_count=MIX_W) + lw["conv_dw_b"].astype(z.dtype)
    y = jax.nn.silu(layer_norm(y, lw["conv_ln_w"], lw["conv_ln_b"]))
    return y, zp[:, -(CONV_W - 1):]


def rel_bias(table, q_off, tq, tk):
    rel = (q_off + jnp.arange(tq))[:, None] - jnp.arange(tk)[None, :]
    return table[:, jnp.clip(rel, -REL_CLIP, REL_CLIP) + REL_CLIP].astype(jnp.float32)


def band_attention_prompt(q, k, v, table):
    B, T, H, Dh = q.shape
    NC = T // CHUNK
    NB = BAND_PAST_CHUNKS + 1
    pad = ((0, 0), (BAND_PAST, 0), (0, 0), (0, 0))
    idx = jnp.arange(NC)[:, None] + jnp.arange(NB)[None, :]
    kb = jnp.pad(k, pad).reshape(B, NC + BAND_PAST_CHUNKS, CHUNK, H, Dh)[:, idx].reshape(B, NC, NB * CHUNK, H, Dh)
    vb = jnp.pad(v, pad).reshape(B, NC + BAND_PAST_CHUNKS, CHUNK, H, Dh)[:, idx].reshape(B, NC, NB * CHUNK, H, Dh)
    qc = q.reshape(B, NC, CHUNK, H, Dh)
    s = jnp.einsum("bcqhd,bckhd->bchqk", qc, kb).astype(jnp.float32) * (Dh ** -0.5)
    s = s + rel_bias(table, BAND_PAST, CHUNK, NB * CHUNK)[None, None]
    valid = (jnp.arange(NC)[:, None] * CHUNK + jnp.arange(NB * CHUNK)[None, :]) >= BAND_PAST
    s = jnp.where(valid[None, :, None, None, :], s, -1e30)
    pr = jax.nn.softmax(s, axis=-1).astype(v.dtype)
    return jnp.einsum("bchqk,bckhd->bcqhd", pr, vb).reshape(B, T, H * Dh)


def band_attention_sample(q, k, v, cache_k, cache_v, table):
    B, T, H, Dh = q.shape
    L = cache_k.shape[1]
    kb = jnp.concatenate([cache_k.astype(k.dtype), k], axis=1)
    vb = jnp.concatenate([cache_v.astype(v.dtype), v], axis=1)
    s = jnp.einsum("bqhd,bkhd->bhqk", q, kb).astype(jnp.float32) * (Dh ** -0.5)
    s = s + rel_bias(table, L, T, L + T)[None]
    pr = jax.nn.softmax(s, axis=-1).astype(v.dtype)
    return jnp.einsum("bhqk,bkhd->bqhd", pr, vb).reshape(B, T, H * Dh)


def hybrid_layer(x, lw, rwkv_shift0, rwkv_S0, conv0, kv_cache):
    B, T, _ = x.shape
    h = rms_norm(x, lw["norm_mix"])
    proj = h @ lw["w_in"]
    o_rwkv, shift_new, S_new = rwkv_mixer(proj[..., OFF_RWKV:OFF_GMLP], rwkv_shift0, rwkv_S0, lw)
    o_gmlp, v_gmlp = gmlp_mixer(proj[..., OFF_GMLP:OFF_CONV], lw)
    o_conv, conv_new = conv_mixer(proj[..., OFF_CONV:OFF_ATTN], conv0, lw)
    qkv = proj[..., OFF_ATTN:OFF_GATE].reshape(B, T, 3, ATTN_HEADS, ATTN_HEAD)
    q, k, v = qkv[:, :, 0], qkv[:, :, 1], qkv[:, :, 2]
    if kv_cache is None:
        o_attn = band_attention_prompt(q, k, v, lw["attn_rel_bias"])
        rows = min(BAND_PAST, T)
        k_new, v_new = k[:, T - rows:], v[:, T - rows:]
    else:
        o_attn = band_attention_sample(q, k, v, kv_cache[0], kv_cache[1], lw["attn_rel_bias"])
        k_new, v_new = k, v
    gates = jax.nn.sigmoid(proj[..., OFF_GATE:])
    branches = (o_rwkv, o_gmlp, o_conv, o_attn)
    merged = gates[..., :D_MODEL] * (branches[0] @ lw["w_branch"][0])
    for n in range(1, N_BRANCH):
        merged = merged + gates[..., n * D_MODEL:(n + 1) * D_MODEL] * (branches[n] @ lw["w_branch"][n])
    x = x + merged @ lw["w_out"]
    h2 = rms_norm(x, lw["norm_ffn"])
    gu = h2 @ lw["w_ffn_in"]
    x = x + (jax.nn.silu(gu[..., :D_FF]) * gu[..., D_FF:]) @ lw["w_ffn_out"]
    return x, (shift_new, S_new, conv_new, k_new, v_new, v_gmlp)


def setup_inputs(seed: int = 0) -> dict:
    key = jax.random.key(seed)
    ks = iter(jax.random.split(key, 40))
    nrm = lambda shape, scale: scale * jax.random.normal(next(ks), shape, jnp.float32)
    uni = lambda shape, lo, hi: jax.random.uniform(next(ks), shape, jnp.float32, lo, hi)
    attn_rows = min(BAND_PAST, PAST_LEN)
    return {
        "x_prompt": nrm((BATCH, SEQ, D_MODEL), 1.0),
        "x_sample": nrm((DEC_BATCH, DEC_SEQ, D_MODEL), 1.0),
        "state_rwkv_shift": nrm((DEPTH, DEC_BATCH, RWKV_COLS), 1.0),
        "state_rwkv_wkv": nrm((DEPTH, DEC_BATCH, RWKV_HEADS, RWKV_HEAD, RWKV_HEAD), 0.5),
        "cache_conv": nrm((DEPTH, DEC_BATCH, CONV_W - 1, MIX_W), 0.5),
        "cache_attn_k": nrm((DEPTH, DEC_BATCH, attn_rows, ATTN_HEADS, ATTN_HEAD), 1.0),
        "cache_attn_v": nrm((DEPTH, DEC_BATCH, attn_rows, ATTN_HEADS, ATTN_HEAD), 1.0),
        "norm_mix": 1.0 + nrm((DEPTH, D_MODEL), 0.02),
        "norm_ffn": 1.0 + nrm((DEPTH, D_MODEL), 0.02),
        "norm_final": 1.0 + nrm((D_MODEL,), 0.02),
        "w_in": nrm((DEPTH, D_MODEL, IN_COLS), D_MODEL ** -0.5),
        "rwkv_mu": uni((DEPTH, RWKV_COLS), 0.0, 1.0),
        "rwkv_w0": uni((DEPTH, MIX_W), -2.5, 1.5),
        "rwkv_w2": nrm((DEPTH, W_RANK, MIX_W), 0.5 * W_RANK ** -0.5),
        "rwkv_a0": nrm((DEPTH, MIX_W), 0.1),
        "rwkv_a2": nrm((DEPTH, A_RANK, MIX_W), 0.5 * A_RANK ** -0.5),
        "rwkv_g2": nrm((DEPTH, G_RANK, MIX_W), G_RANK ** -0.5),
        "rwkv_kk": 0.85 + nrm((DEPTH, MIX_W), 0.02),
        "rwkv_ka": 1.0 + nrm((DEPTH, MIX_W), 0.02),
        "rwkv_rk": nrm((DEPTH, RWKV_HEADS, RWKV_HEAD), 0.1),
        "rwkv_gn_w": 1.0 + nrm((DEPTH, MIX_W), 0.02),
        "rwkv_gn_b": nrm((DEPTH, MIX_W), 0.02),
        "gmlp_ln_w": 1.0 + nrm((DEPTH, MIX_W), 0.02),
        "gmlp_ln_b": nrm((DEPTH, MIX_W), 0.02),
        "gmlp_ws": nrm((DEPTH, GMLP_GROUPS, GMLP_CHUNK, GMLP_CHUNK), 0.5 * GMLP_CHUNK ** -0.5),
        "gmlp_bs": 1.0 + nrm((DEPTH, GMLP_GROUPS, GMLP_CHUNK), 0.1),
        "conv_dw": nrm((DEPTH, CONV_W, MIX_W), CONV_W ** -0.5),
        "conv_dw_b": nrm((DEPTH, MIX_W), 0.02),
        "conv_ln_w": 1.0 + nrm((DEPTH, MIX_W), 0.02),
        "conv_ln_b": nrm((DEPTH, MIX_W), 0.02),
        "attn_rel_bias": nrm((DEPTH, ATTN_HEADS, 2 * REL_CLIP + 1), 0.2),
        "w_branch": nrm((DEPTH, N_BRANCH, MIX_W, D_MODEL), MIX_W ** -0.5),
        "w_out": nrm((DEPTH, D_MODEL, D_MODEL), 0.5 * D_MODEL ** -0.5),
        "w_ffn_in": nrm((DEPTH, D_MODEL, 2 * D_FF), D_MODEL ** -0.5),
        "w_ffn_out": nrm((DEPTH, D_FF, D_MODEL), 0.5 * D_FF ** -0.5),
    }


def reference(x_prompt, x_sample, state_rwkv_shift, state_rwkv_wkv, cache_conv, cache_attn_k, cache_attn_v,
              norm_mix, norm_ffn, norm_final, w_in, rwkv_mu, rwkv_w0, rwkv_w2, rwkv_a0, rwkv_a2, rwkv_g2,
              rwkv_kk, rwkv_ka, rwkv_rk, rwkv_gn_w, rwkv_gn_b, gmlp_ln_w, gmlp_ln_b, gmlp_ws, gmlp_bs,
              conv_dw, conv_dw_b, conv_ln_w, conv_ln_b, attn_rel_bias, w_branch, w_out, w_ffn_in, w_ffn_out):
    B = x_prompt.shape[0]
    dt = x_prompt.dtype
    xp, xs = x_prompt, x_sample
    p_states = ([], [], [], [], [])
    s_states = ([], [], [], [], [], [])
    for l in range(DEPTH):
        lw = {
            "norm_mix": norm_mix[l], "norm_ffn": norm_ffn[l], "w_in": w_in[l],
            "rwkv_mu": rwkv_mu[l], "rwkv_w0": rwkv_w0[l], "rwkv_w2": rwkv_w2[l], "rwkv_a0": rwkv_a0[l],
            "rwkv_a2": rwkv_a2[l], "rwkv_g2": rwkv_g2[l], "rwkv_kk": rwkv_kk[l], "rwkv_ka": rwkv_ka[l],
            "rwkv_rk": rwkv_rk[l], "rwkv_gn_w": rwkv_gn_w[l], "rwkv_gn_b": rwkv_gn_b[l],
            "gmlp_ln_w": gmlp_ln_w[l], "gmlp_ln_b": gmlp_ln_b[l], "gmlp_ws": gmlp_ws[l], "gmlp_bs": gmlp_bs[l],
            "conv_dw": conv_dw[l], "conv_dw_b": conv_dw_b[l], "conv_ln_w": conv_ln_w[l], "conv_ln_b": conv_ln_b[l],
            "attn_rel_bias": attn_rel_bias[l], "w_branch": w_branch[l], "w_out": w_out[l],
            "w_ffn_in": w_ffn_in[l], "w_ffn_out": w_ffn_out[l],
        }
        xp, st = hybrid_layer(xp, lw,
                              jnp.zeros((B, RWKV_COLS), dt),
                              jnp.zeros((B, RWKV_HEADS, RWKV_HEAD, RWKV_HEAD), dt),
                              jnp.zeros((B, CONV_W - 1, MIX_W), dt),
                              None)
        for lst, val in zip(p_states, st[:5]):
            lst.append(val)
        xs, st = hybrid_layer(xs, lw, state_rwkv_shift[l], state_rwkv_wkv[l], cache_conv[l],
                              (cache_attn_k[l], cache_attn_v[l]))
        for lst, val in zip(s_states, st):
            lst.append(val)
    y_prompt = rms_norm(xp, norm_final)
    y_sample = rms_norm(xs, norm_final)
    p_rwkv_shift, p_rwkv_wkv, p_conv, p_attn_k, p_attn_v = [jnp.stack(v_) for v_ in p_states]
    s_rwkv_shift, s_rwkv_wkv, s_conv, s_attn_k, s_attn_v, s_gmlp_v = [jnp.stack(v_) for v_ in s_states]
    return (y_prompt, y_sample, p_rwkv_shift, p_rwkv_wkv, p_conv, p_attn_k, p_attn_v,
            s_rwkv_shift, s_rwkv_wkv, s_conv, s_attn_k, s_attn_v, s_gmlp_v)
```

```cpp
#include <hip/hip_runtime.h>
#include <cstdio>
#include <cstdint>

#define LAS __attribute__((address_space(3)))
typedef unsigned short bf16_t;
typedef short bf16x8 __attribute__((ext_vector_type(8)));
typedef short s16x4 __attribute__((ext_vector_type(4)));
typedef float f32x4 __attribute__((ext_vector_type(4)));
typedef float f32x2 __attribute__((ext_vector_type(2)));
typedef unsigned u32x4 __attribute__((ext_vector_type(4)));
typedef unsigned u32x2 __attribute__((ext_vector_type(2)));

#ifndef ONE_LAUNCH
#define ONE_LAUNCH 1
#endif
#ifndef PHMASK
#define PHMASK 0xFFFFFFFFu
#endif
#define EN(k) (((PHMASK) >> (k)) & 1u)
#ifndef DUPMASK
#define DUPMASK 0u
#endif
#define REP(k) for (int rep_ = 0; rep_ < 1 + (int)(((DUPMASK) >> (k)) & 1u); ++rep_)

constexpr int DM = 2048, NB = 8, SEQ = 2048, NL = 4, SB = 8, ST = 16;
constexpr int NPR = NB * SEQ, NSA = SB * ST, MR = NPR + NSA, MP = 16640;
constexpr int RC = 1984, INC = 13760, NPJ = 13824, DFF = 5632;
constexpr int GM_OFF = 2048, CV_OFF = 3072, AT_OFF = 4096, GT_OFF = 5632;
constexpr int NTHR = 512, NWAVE = 8;
constexpr int LDS_BYTES = 155648;
constexpr int LDS_BAR_OFF = 155648 - 64;

constexpr size_t O_YP = 0, O_YS = O_YP + (size_t)NPR * DM, O_PSH = O_YS + (size_t)NSA * DM, O_PWKV = O_PSH + (size_t)NL * NB * RC,
                 O_PCV = O_PWKV + (size_t)NL * NB * 8 * 64 * 64, O_PK = O_PCV + (size_t)NL * NB * 30 * 512, O_PV = O_PK + (size_t)NL * NB * 512 * 512,
                 O_SSH = O_PV + (size_t)NL * NB * 512 * 512, O_SWKV = O_SSH + (size_t)NL * SB * RC, O_SCV = O_SWKV + (size_t)NL * SB * 8 * 64 * 64,
                 O_SK = O_SCV + (size_t)NL * SB * 30 * 512, O_SV = O_SK + (size_t)NL * SB * ST * 512, O_SGV = O_SV + (size_t)NL * SB * ST * 512,
                 O_END = O_SGV + (size_t)NL * SB * ST * 512;

constexpr size_t WS_CTL = 0, CTL_BYTES = 1u << 20;
constexpr size_t WS_WIN = WS_CTL + CTL_BYTES;
constexpr size_t WS_WBR = WS_WIN + (size_t)NL * NPJ * DM * 2;
constexpr size_t WS_WOUT = WS_WBR + (size_t)NL * DM * DM * 2;
constexpr size_t WS_WFI = WS_WOUT + (size_t)NL * DM * DM * 2;
constexpr size_t WS_WFO = WS_WFI + (size_t)NL * 2 * DFF * DM * 2;
constexpr size_t WS_W2T = WS_WFO + (size_t)NL * DM * DFF * 2;
constexpr size_t WS_A2T = WS_W2T + (size_t)NL * 512 * 96 * 2;
constexpr size_t WS_G2T = WS_A2T + (size_t)NL * 512 * 96 * 2;
constexpr size_t WS_WSB = WS_G2T + (size_t)NL * 512 * 256 * 2;
constexpr size_t WS_CK = WS_WSB + (size_t)NL * 8 * 128 * 128 * 2;
constexpr size_t WS_CVV = WS_CK + (size_t)NL * SB * 512 * 512 * 2;
constexpr size_t WS_X = WS_CVV + (size_t)NL * SB * 512 * 512 * 2;
constexpr size_t WS_H = WS_X + (size_t)MP * DM * 4;
constexpr size_t WS_PROJ = WS_H + (size_t)MP * DM * 2;
constexpr size_t WS_OCAT = WS_PROJ + (size_t)MP * NPJ * 2;
constexpr size_t WS_MRG = WS_OCAT + (size_t)MP * DM * 2;
constexpr size_t WS_SCAN = WS_MRG + (size_t)MP * DM * 2;
constexpr size_t SCAN_ARR = (size_t)MR * 512 * 4;
constexpr size_t WS_G = WS_SCAN + 6 * SCAN_ARR;
constexpr size_t WS_Y = WS_G + SCAN_ARR;
constexpr size_t WS_BON = WS_Y + SCAN_ARR;
constexpr size_t WS_SHS = WS_BON + (size_t)MR * 8 * 4;
constexpr size_t WS_ZROW = WS_SHS + (size_t)NL * SB * 2048 * 2;
constexpr int REC_BYTES = 14336, REC_FV = 11264, REC_G16 = 13312;
constexpr size_t WS_REC = WS_ZROW + 4096;
constexpr size_t WS_END = WS_REC + (size_t)(MR / 16) * 8 * REC_BYTES;

struct Params { const float* in[35]; float* out; unsigned char* ws; int lo, hi; };

typedef __bf16 bf16x2_t __attribute__((ext_vector_type(2)));
__device__ __forceinline__ unsigned pk2(float lo, float hi) { const f32x2 v = {lo, hi}; const bf16x2_t b = __builtin_convertvector(v, bf16x2_t); return __builtin_bit_cast(unsigned, b); }
__device__ __forceinline__ float bflo(unsigned u) { return __uint_as_float(u << 16); }
__device__ __forceinline__ float bfhi(unsigned u) { return __uint_as_float(u & 0xffff0000u); }
__device__ __forceinline__ float bf1(bf16_t b) { return __uint_as_float(((unsigned)b) << 16); }
__device__ __forceinline__ float fexp(float x) { return __builtin_amdgcn_exp2f(x * 1.44269504089f); }
__device__ __forceinline__ float frcp(float x) { return __builtin_amdgcn_rcpf(x); }
__device__ __forceinline__ float sigm(float x) { return frcp(1.0f + fexp(-x)); }
__device__ __forceinline__ float ftanh(float x) { return 1.0f - 2.0f * frcp(1.0f + fexp(2.0f * x)); }
__device__ __forceinline__ float gelu_t(float x) { const float u = 1.5957691216f * (x + 0.044715f * x * x * x); return x * sigm(u); }
__device__ __forceinline__ float wave_sum(float v) {
#pragma unroll
    for (int o = 32; o >= 1; o >>= 1) v += __shfl_xor(v, o);
    return v;
}
__device__ __forceinline__ float row16_sum(float v) {
    v += __int_as_float(__builtin_amdgcn_update_dpp(0, __float_as_int(v), 0xB1, 0xF, 0xF, true));
    v += __int_as_float(__builtin_amdgcn_update_dpp(0, __float_as_int(v), 0x4E, 0xF, 0xF, true));
    v += __int_as_float(__builtin_amdgcn_update_dpp(0, __float_as_int(v), 0x141, 0xF, 0xF, true));
    v += __int_as_float(__builtin_amdgcn_update_dpp(0, __float_as_int(v), 0x140, 0xF, 0xF, true));
    return v;
}
typedef short v4i16_t __attribute__((ext_vector_type(4)));
__device__ __forceinline__ s16x4 lds_tr(LAS unsigned char* p) { return __builtin_bit_cast(s16x4, __builtin_amdgcn_ds_read_tr16_b64_v4i16((LAS v4i16_t*)p)); }
__device__ __forceinline__ bf16x8 cat8(s16x4 a, s16x4 b) { return __builtin_shufflevector(a, b, 0, 1, 2, 3, 4, 5, 6, 7); }
__device__ __forceinline__ void ub8(const u32x2 w, float (&f)[8]) {
    f[0] = (float)((w.x >> 0) & 0xffu); f[1] = (float)((w.x >> 8) & 0xffu); f[2] = (float)((w.x >> 16) & 0xffu); f[3] = (float)((w.x >> 24) & 0xffu);
    f[4] = (float)((w.y >> 0) & 0xffu); f[5] = (float)((w.y >> 8) & 0xffu); f[6] = (float)((w.y >> 16) & 0xffu); f[7] = (float)((w.y >> 24) & 0xffu);
}
__device__ __forceinline__ unsigned gq(float g) { return (unsigned)fminf(fmaxf(g * 255.0f + 0.5f, 1.0f), 255.0f); }
__device__ __forceinline__ void unpack8(const u32x4 w, float (&f)[8]) {
    f[0] = bflo(w.x); f[1] = bfhi(w.x); f[2] = bflo(w.y); f[3] = bfhi(w.y); f[4] = bflo(w.z); f[5] = bfhi(w.z); f[6] = bflo(w.w); f[7] = bfhi(w.w);
}

namespace pg8 {
#define PG8_LAS __attribute__((address_space(3)))
constexpr int BM = 256, BK = 64, HALF = 128, HTB = HALF * BK * 2, STAGE_BYTES = 8 * HTB, NXCD = 8, WGM = 8;
__host__ __device__ __forceinline__ int lds_byte(int r, int c) { const int st = (r >> 4) * 2 + (c >> 5), rr = r & 15, cc = c & 31, ob = rr * 64 + cc * 2; return st * 1024 + (ob ^ (((ob >> 9) & 1) << 5)); }
__host__ __device__ __forceinline__ void stage_rc(int b, int& R, int& C) { const int st = b / 1024, sb = b % 1024, swz = sb ^ (((sb >> 9) & 1) << 5); R = (st >> 1) * 16 + swz / 64; C = (st & 1) * 32 + (swz % 64) / 2; }
__host__ __device__ __forceinline__ int perm32(int rho) { const int n = rho >> 4, i = rho & 15; return 8 * (i >> 2) + 4 * n + (i & 3); }
struct Unit { int pm, pn; };
struct Gemm { const bf16_t* A; const bf16_t* Bt; int M, N, K; };
struct StaticOrder {
    int nM, nN, nwg, G, c;
    __host__ __device__ void init(int M, int N, int G_, int c_) { nM = M / BM; nN = N / BM; nwg = nM * nN; G = G_; c = c_; }
    __host__ __device__ bool next(int i, Unit& u) const {
        const long L = (long)i * G + c; if (L >= nwg) return false;
        int wgid = (int)L; { const int q = nwg / NXCD, r = nwg % NXCD, xcd = wgid % NXCD, off = wgid / NXCD; wgid = (xcd < r ? xcd * (q + 1) : r * (q + 1) + (xcd - r) * q) + off; }
        const int nig = WGM * nN, gid = wgid / nig, fm = gid * WGM, gsz = (nM - fm) < WGM ? (nM - fm) : WGM;
        u.pm = fm + ((wgid % nig) % gsz); u.pn = (wgid % nig) / gsz; return true;
    }
    __device__ __forceinline__ void a_ready(const Unit&) const {}
    __device__ __forceinline__ void done(const Unit&) const {}
};

struct EpiProj {
    static constexpr bool PERM = true, AFTER_DRAIN = false, MID = false;
    bf16_t* O;
    __device__ __forceinline__ void mid(f32x4 (&)[2][2][4][2], const Unit&, int, int, int, int, int) const {}
    __device__ __forceinline__ void operator()(f32x4 (&acc)[2][2][4][2], const Unit& u, int wr, int wc, int fr, int fq) const {
        const int row0 = u.pm * BM + wr * 64 + fr, col0 = u.pn * BM + wc * 64 + 8 * fq; const bool gate = u.pn >= (GT_OFF / 256);
#pragma unroll
        for (int ai = 0; ai < 2; ++ai)
#pragma unroll
            for (int m = 0; m < 4; ++m) { bf16_t* rowp = O + (size_t)(row0 + ai * HALF + m * 16) * NPJ + col0;
#pragma unroll
                for (int bj = 0; bj < 2; ++bj) { const f32x4 v0 = acc[ai][bj][m][0], v1 = acc[ai][bj][m][1];
                    if (gate) {
                        u32x2 q; q.x = gq(sigm(v0[0])) | (gq(sigm(v0[1])) << 8) | (gq(sigm(v0[2])) << 16) | (gq(sigm(v0[3])) << 24); q.y = gq(sigm(v1[0])) | (gq(sigm(v1[1])) << 8) | (gq(sigm(v1[2])) << 16) | (gq(sigm(v1[3])) << 24);
                        *(u32x2*)((unsigned char*)(rowp - col0 + GT_OFF) + (col0 - GT_OFF) + bj * 32) = q;
                    } else {
                        u32x4 w; w.x = pk2(v0[0], v0[1]); w.y = pk2(v0[2], v0[3]); w.z = pk2(v1[0], v1[1]); w.w = pk2(v1[2], v1[3]);
                        *(u32x4*)(rowp + bj * 32) = w; } } }
    }
};
struct EpiSwiGLU {
    static constexpr bool PERM = true, AFTER_DRAIN = false, MID = false;
    bf16_t* O;
    __device__ __forceinline__ void mid(f32x4 (&)[2][2][4][2], const Unit&, int, int, int, int, int) const {}
    __device__ __forceinline__ void operator()(f32x4 (&acc)[2][2][4][2], const Unit& u, int wr, int wc, int fr, int fq) const {
        const int row0 = u.pm * BM + wr * 64 + fr, col0 = u.pn * HALF + wc * 32 + 8 * fq;
#pragma unroll
        for (int ai = 0; ai < 2; ++ai)
#pragma unroll
            for (int m = 0; m < 4; ++m) { bf16_t* rowp = O + (size_t)(row0 + ai * HALF + m * 16) * DFF + col0;
                f32x4 v0, v1;
#pragma unroll
                for (int j = 0; j < 4; ++j) { const float g0 = acc[ai][0][m][0][j], g1 = acc[ai][0][m][1][j]; v0[j] = g0 * sigm(g0) * acc[ai][1][m][0][j]; v1[j] = g1 * sigm(g1) * acc[ai][1][m][1][j]; }
                u32x4 w; w.x = pk2(v0[0], v0[1]); w.y = pk2(v0[2], v0[3]); w.z = pk2(v1[0], v1[1]); w.w = pk2(v1[2], v1[3]);
                *(u32x4*)rowp = w; }
    }
};
struct EpiResid {
    static constexpr bool PERM = true, AFTER_DRAIN = false, MID = false;
    bf16_t* X;
    __device__ __forceinline__ void mid(f32x4 (&)[2][2][4][2], const Unit&, int, int, int, int, int) const {}
    __device__ __forceinline__ void operator()(f32x4 (&acc)[2][2][4][2], const Unit& u, int wr, int wc, int fr, int fq) const {
        const int row0 = u.pm * BM + wr * 64 + fr, col0 = u.pn * BM + wc * 32 + 8 * fq;
#pragma unroll
        for (int ai = 0; ai < 2; ++ai) { u32x4 xb[4][2];
#pragma unroll
            for (int m = 0; m < 4; ++m) { const bf16_t* rowp = X + (size_t)(row0 + ai * HALF + m * 16) * DM + col0;
#pragma unroll
                for (int bj = 0; bj < 2; ++bj) xb[m][bj] = *(const u32x4*)(rowp + bj * HALF); }
            __builtin_amdgcn_sched_barrier(0);
#pragma unroll
            for (int m = 0; m < 4; ++m) { bf16_t* rowp = X + (size_t)(row0 + ai * HALF + m * 16) * DM + col0;
#pragma unroll
                for (int bj = 0; bj < 2; ++bj) { float f[8]; unpack8(xb[m][bj], f);
                    const f32x4 v0 = acc[ai][bj][m][0], v1 = acc[ai][bj][m][1];
                    u32x4 w; w.x = pk2(f[0] + v0[0], f[1] + v0[1]); w.y = pk2(f[2] + v0[2], f[3] + v0[3]); w.z = pk2(f[4] + v1[0], f[5] + v1[1]); w.w = pk2(f[6] + v1[2], f[7] + v1[3]);
                    *(u32x4*)(rowp + bj * HALF) = w; } }
            __builtin_amdgcn_sched_barrier(0); }
    }
};
struct EpiMerged {
    static constexpr bool PERM = true, AFTER_DRAIN = false, MID = true;
    bf16_t* O; const bf16_t* G;
    __device__ __forceinline__ void mid(f32x4 (&acc)[2][2][4][2], const Unit& u, int b, int wr, int wc, int fr, int fq) const {
        int row0 = u.pm * BM + wr * 64 + fr, col0 = u.pn * BM + wc * 32 + 8 * fq;
        asm volatile("" : "+v"(row0), "+v"(col0));
        u32x2 ga[2][4][2], gb[2][4][2];
#pragma unroll
        for (int ai = 0; ai < 2; ++ai)
#pragma unroll
            for (int m = 0; m < 4; ++m) { const unsigned char* gp = (const unsigned char*)(G + (size_t)(row0 + ai * HALF + m * 16) * NPJ) + b * DM + col0;
#pragma unroll
                for (int bj = 0; bj < 2; ++bj) { ga[ai][m][bj] = *(const u32x2*)(gp + bj * HALF); gb[ai][m][bj] = *(const u32x2*)(gp + DM + bj * HALF); } }
        __builtin_amdgcn_sched_barrier(0);
#pragma unroll
        for (int ai = 0; ai < 2; ++ai)
#pragma unroll
            for (int m = 0; m < 4; ++m)
#pragma unroll
                for (int bj = 0; bj < 2; ++bj) { float fa[8], fb[8]; ub8(ga[ai][m][bj], fa); ub8(gb[ai][m][bj], fb);
#pragma unroll
                    for (int j = 0; j < 4; ++j) { acc[ai][bj][m][0][j] *= fa[j] * frcp(fb[j]); acc[ai][bj][m][1][j] *= fa[4 + j] * frcp(fb[4 + j]); } }
        __builtin_amdgcn_sched_barrier(0);
    }
    __device__ __forceinline__ void operator()(f32x4 (&acc)[2][2][4][2], const Unit& u, int wr, int wc, int fr, int fq) const {
        const int row0 = u.pm * BM + wr * 64 + fr, col0 = u.pn * BM + wc * 32 + 8 * fq;
#pragma unroll
        for (int ai = 0; ai < 2; ++ai) { u32x2 ga[4][2];
#pragma unroll
            for (int m = 0; m < 4; ++m) { const unsigned char* gp = (const unsigned char*)(G + (size_t)(row0 + ai * HALF + m * 16) * NPJ) + 3 * DM + col0;
#pragma unroll
                for (int bj = 0; bj < 2; ++bj) ga[m][bj] = *(const u32x2*)(gp + bj * HALF); }
            __builtin_amdgcn_sched_barrier(0);
#pragma unroll
            for (int m = 0; m < 4; ++m) { bf16_t* rowp = O + (size_t)(row0 + ai * HALF + m * 16) * DM + col0;
#pragma unroll
                for (int bj = 0; bj < 2; ++bj) { float fa[8]; ub8(ga[m][bj], fa);
#pragma unroll
                    for (int j = 0; j < 8; ++j) fa[j] *= (1.0f / 255.0f);
                    const f32x4 v0 = acc[ai][bj][m][0], v1 = acc[ai][bj][m][1];
                    u32x4 w; w.x = pk2(v0[0] * fa[0], v0[1] * fa[1]); w.y = pk2(v0[2] * fa[2], v0[3] * fa[3]); w.z = pk2(v1[0] * fa[4], v1[1] * fa[5]); w.w = pk2(v1[2] * fa[6], v1[3] * fa[7]);
                    *(u32x4*)(rowp + bj * HALF) = w; } }
            __builtin_amdgcn_sched_barrier(0); }
    }
};

struct EpiAny {
    int mode;
    bf16_t* O; const bf16_t* G; bf16_t* X;
    __device__ __forceinline__ bool perm() const { return true; }
    __device__ __forceinline__ bool wide() const { return mode == 0; }
    __device__ __forceinline__ void mid(f32x4 (&acc)[2][2][4][2], const Unit& u, int b, int wr, int wc, int fr, int fq) const { EpiMerged E{O, G}; E.mid(acc, u, b, wr, wc, fr, fq); }
    __device__ __forceinline__ void operator()(f32x4 (&acc)[2][2][4][2], const Unit& u, int wr, int wc, int fr, int fq) const {
        if (mode == 0) { EpiProj E{O}; E(acc, u, wr, wc, fr, fq); }
        else if (mode == 1) { EpiMerged E{O, G}; E(acc, u, wr, wc, fr, fq); }
        else if (mode == 2) { EpiResid E{X}; E(acc, u, wr, wc, fr, fq); }
        else { EpiSwiGLU E{O}; E(acc, u, wr, wc, fr, fq); }
    }
};

template <class Epi, class Sched>
__device__ __forceinline__ void gemm_phase(PG8_LAS unsigned char* lds, const Gemm g, const Sched& S, const Epi& E, const int tid) {
    const int wid = __builtin_amdgcn_readfirstlane(tid >> 6), lane = tid & 63, wr = wid >> 2, wc = wid & 3, fr = lane & 15, fq = lane >> 4;
    const int K = g.K, nt = K / BK;
    unsigned voffA[2], voffB[2];
#pragma unroll
    for (int i = 0; i < 2; ++i) { int R, C; stage_rc(tid * 16 + i * 8192, R, C); const int Rb = E.wide() ? 64 * (R >> 5) + perm32(R & 31) : E.perm() ? ((R & ~31) + perm32(R & 31)) : R;
        voffA[i] = (unsigned)(R * K + C) * 2u; voffB[i] = (unsigned)(Rb * K + C) * 2u; }
    const size_t kstep = (size_t)(BK * 2);
    const size_t hstep = (size_t)HALF * K * 2;
    const size_t tstep = 2 * hstep;
    const size_t hstepB = E.wide() ? (size_t)32 * K * 2 : hstep;
    const unsigned ldsw = (unsigned)wid * 1024u;
    const int aoff = lds_byte(wr * 64 + fr, fq * 8), boff = lds_byte(wc * 32 + fr, fq * 8);
#define PG8_SA(b, h) (((b) * 2 + (h)) * HTB)
#define PG8_SB(b, h) ((4 + (b) * 2 + (h)) * HTB)
#define PG8_STAGE(bufoff, gbase, voff) do { _Pragma("unroll") for (int _i = 0; _i < 2; ++_i) \
        __builtin_amdgcn_global_load_lds((const unsigned*)((const char*)(gbase) + (voff)[_i]), (PG8_LAS unsigned*)(lds + (bufoff) + ldsw + _i * 8192), 16, 0, 0); } while (0)
#define PG8_LDA(dst, b, h) do { _Pragma("unroll") for (int m = 0; m < 4; ++m) _Pragma("unroll") for (int k = 0; k < 2; ++k) dst[m][k] = *(const PG8_LAS bf16x8*)(lds + PG8_SA(b, h) + aoff + m * 2048 + k * 1024); } while (0)
#define PG8_LDB(dst, b, h) do { _Pragma("unroll") for (int n = 0; n < 2; ++n) _Pragma("unroll") for (int k = 0; k < 2; ++k) dst[n][k] = *(const PG8_LAS bf16x8*)(lds + PG8_SB(b, h) + boff + n * 2048 + k * 1024); } while (0)
#define PG8_MMA(ai, bj, At, Bt) do { __builtin_amdgcn_s_setprio(1); _Pragma("unroll") for (int m = 0; m < 4; ++m) _Pragma("unroll") for (int n = 0; n < 2; ++n) _Pragma("unroll") for (int k = 0; k < 2; ++k) \
        acc[ai][bj][m][n] = __builtin_amdgcn_mfma_f32_16x16x32_bf16(Bt[n][k], At[m][k], acc[ai][bj][m][n], 0, 0, 0); __builtin_amdgcn_s_setprio(0); } while (0)
#define PG8_WAIT_V(n) asm volatile("s_waitcnt vmcnt(" #n ")" ::: "memory")
#define PG8_WAIT_L(n) asm volatile("s_waitcnt lgkmcnt(" #n ")" ::: "memory")
#define PG8_BAR __builtin_amdgcn_s_barrier()
#define PG8_SCHED __builtin_amdgcn_sched_barrier(0)
    Unit cur, nxt; int ui = 0;
    if (!S.next(0, cur)) return;
    f32x4 acc[2][2][4][2];
#pragma unroll
    for (int a = 0; a < 2; ++a)
#pragma unroll
        for (int b = 0; b < 2; ++b)
#pragma unroll
            for (int m = 0; m < 4; ++m)
#pragma unroll
                for (int n = 0; n < 2; ++n) acc[a][b][m][n] = (f32x4){0.f, 0.f, 0.f, 0.f};
    bf16x8 At[4][2], B0[2][2], B1[2][2];
    const char* cA = (const char*)g.A + (size_t)cur.pm * tstep; const char* cB = (const char*)g.Bt + (size_t)cur.pn * tstep;
    S.a_ready(cur);
    PG8_STAGE(PG8_SB(0, 0), cB, voffB); PG8_STAGE(PG8_SB(0, 1), cB + hstepB, voffB); PG8_STAGE(PG8_SA(0, 0), cA, voffA); PG8_STAGE(PG8_SA(0, 1), cA + hstep, voffA);
    if (wr == 1) PG8_BAR;
    PG8_WAIT_V(2); PG8_BAR;
    PG8_STAGE(PG8_SB(1, 0), cB + kstep, voffB); PG8_STAGE(PG8_SA(1, 0), cA + kstep, voffA); PG8_STAGE(PG8_SB(1, 1), cB + hstepB + kstep, voffB);
    PG8_WAIT_V(6); PG8_BAR;
    for (;;) {
        const bool has_next = S.next(ui + 1, nxt);
        const char* nA = has_next ? (const char*)g.A + (size_t)nxt.pm * tstep : cA; const char* nB = has_next ? (const char*)g.Bt + (size_t)nxt.pn * tstep : cB;
        for (int t = 0; t < nt; t += 2) {
            const bool last = (t == nt - 2);
            const char* a1 = cA + (size_t)(t + 1) * kstep;
            const char* a2 = last ? nA : cA + (size_t)(t + 2) * kstep; const char* b2 = last ? nB : cB + (size_t)(t + 2) * kstep;
            const char* a3 = a2 + kstep; const char* b3 = b2 + kstep;
            if (last && has_next) S.a_ready(nxt);
            PG8_LDB(B0, 0, 0); PG8_LDB(B1, 0, 1); PG8_SCHED; PG8_LDA(At, 0, 0); PG8_STAGE(PG8_SA(1, 1), a1 + hstep, voffA);
            PG8_WAIT_V(8); PG8_WAIT_L(0); PG8_BAR; PG8_MMA(0, 0, At, B0); PG8_MMA(0, 1, At, B1); PG8_BAR; PG8_SCHED;
            PG8_LDA(At, 0, 1); PG8_STAGE(PG8_SB(0, 0), b2, voffB); PG8_STAGE(PG8_SB(0, 1), b2 + hstepB, voffB); PG8_STAGE(PG8_SA(0, 0), a2, voffA);
            PG8_WAIT_V(8); PG8_WAIT_L(0); PG8_BAR; PG8_MMA(1, 0, At, B0); PG8_MMA(1, 1, At, B1); PG8_BAR; PG8_SCHED;
            PG8_LDB(B0, 1, 0); PG8_LDB(B1, 1, 1); PG8_SCHED; PG8_LDA(At, 1, 0); PG8_STAGE(PG8_SA(0, 1), a2 + hstep, voffA);
            PG8_WAIT_V(8); PG8_WAIT_L(0); PG8_BAR; PG8_MMA(0, 0, At, B0); PG8_MMA(0, 1, At, B1); PG8_BAR; PG8_SCHED;
            PG8_LDA(At, 1, 1); PG8_STAGE(PG8_SB(1, 0), b3, voffB); PG8_STAGE(PG8_SB(1, 1), b3 + hstepB, voffB); PG8_STAGE(PG8_SA(1, 0), a3, voffA);
            PG8_WAIT_V(8); PG8_WAIT_L(0); PG8_BAR; PG8_MMA(1, 0, At, B0); PG8_MMA(1, 1, At, B1); PG8_BAR; PG8_SCHED;
            if (E.mode == 1 && !last && ((t + 2) & 7) == 0) E.mid(acc, cur, ((t + 2) >> 3) - 1, wr, wc, fr, fq);
        }
        if (wr == 0) PG8_BAR;
        E(acc, cur, wr, wc, fr, fq); S.done(cur);
        if (!has_next) break;
#pragma unroll
        for (int a = 0; a < 2; ++a)
#pragma unroll
            for (int b = 0; b < 2; ++b)
#pragma unroll
                for (int m = 0; m < 4; ++m)
#pragma unroll
                    for (int n = 0; n < 2; ++n) acc[a][b][m][n] = (f32x4){0.f, 0.f, 0.f, 0.f};
        cur = nxt; cA = nA; cB = nB; ++ui;
        if (wr == 1) PG8_BAR;
    }
    PG8_WAIT_V(0);
    PG8_BAR;
#undef PG8_SA
#undef PG8_SB
#undef PG8_STAGE
#undef PG8_LDA
#undef PG8_LDB
#undef PG8_MMA
#undef PG8_WAIT_V
#undef PG8_WAIT_L
#undef PG8_BAR
#undef PG8_SCHED
}
}

#define XB_TMO      128
#define XB_XCNT(j)  (256  + 64 * (j))
#define XB_XSUB(j)  (1280 + 64 * (j))
#define XB_XGEN(j)  (2304 + 64 * (j))
#define XB_TOP      3328
#define XB_TOPGEN   3392
#define XCD_BAR_WORDS 3456
#define XB_SPIN_CAP (1u << 18)
__device__ __forceinline__ unsigned xb_ld(unsigned* p)              { return __hip_atomic_load(p, __ATOMIC_RELAXED, __HIP_MEMORY_SCOPE_AGENT); }
__device__ __forceinline__ unsigned xb_add(unsigned* p, unsigned v) { return __hip_atomic_fetch_add(p, v, __ATOMIC_RELAXED, __HIP_MEMORY_SCOPE_AGENT); }
__device__ __forceinline__ unsigned xb_xcc_id() { return (unsigned)__builtin_amdgcn_s_getreg((3 << 11) | 20) & 0xFu; }
#define XB_SPIN(cond, bar) do { unsigned _sp = 0; while (cond) { __builtin_amdgcn_s_sleep(1); \
    if ((++_sp & 255u) == 0u) { if (xb_ld(&(bar)[XB_TMO])) break; if (_sp > XB_SPIN_CAP) { atomicAdd(&(bar)[XB_TMO], 1u); break; } } } } while (0)
struct XcdBarrier { unsigned* bar; unsigned x; volatile LAS unsigned* st; };
__device__ __forceinline__ XcdBarrier xcd_barrier_post(unsigned* bar, volatile LAS unsigned* st) {
    XcdBarrier b; b.bar = bar; b.x = xb_xcc_id(); b.st = st;
    if (threadIdx.x == 0) (void)xb_add(&bar[XB_XCNT(b.x)], 1u);
    return b;
}
__device__ __forceinline__ void xcd_barrier_complete(unsigned* bar, unsigned x, unsigned& nloc, unsigned& nx) {
    const unsigned G = gridDim.x * gridDim.y * gridDim.z;
    unsigned sum, cnt, mine, sp = 0u;
    for (;;) {
        sum = 0u; cnt = 0u; mine = 0u;
#pragma unroll
        for (unsigned j = 0; j < 16; ++j) { const unsigned c = xb_ld(&bar[XB_XCNT(j)]); sum += c; cnt += (c > 0u) ? 1u : 0u; mine = (j == x) ? c : mine; }
        if (sum == G) break;
        __builtin_amdgcn_s_sleep(1);
        if ((++sp & 255u) == 0u) { if (xb_ld(&bar[XB_TMO])) break; if (sp > XB_SPIN_CAP) { atomicAdd(&bar[XB_TMO], 1u); break; } }
    }
    nloc = mine > 0u ? mine : 1u; nx = cnt > 0u ? cnt : 1u;
}
__device__ __forceinline__ void xcd_barrier(const XcdBarrier& b) {
    asm volatile("s_waitcnt vmcnt(0)" ::: "memory");
    __syncthreads();
    if (threadIdx.x == 0) {
        unsigned* bar = b.bar;
        __builtin_amdgcn_s_waitcnt(0);
        unsigned nloc = b.st[0], nx = b.st[1];
        if (nloc == 0u) { xcd_barrier_complete(bar, b.x, nloc, nx); b.st[0] = nloc; b.st[1] = nx; }
        const unsigned old = xb_add(&bar[XB_XSUB(b.x)], 1u);
        const unsigned gen = old / nloc;
        if (old + 1u == (gen + 1u) * nloc) {
            __builtin_amdgcn_fence(__ATOMIC_RELEASE, "agent");
            asm volatile("s_waitcnt vmcnt(0)" ::: "memory");
            const unsigned og = xb_add(&bar[XB_TOP], 1u);
            const unsigned tg = og / nx;
            if (og + 1u == (tg + 1u) * nx) xb_add(&bar[XB_TOPGEN], 1u);
            else XB_SPIN(xb_ld(&bar[XB_TOPGEN]) == tg, bar);
            __builtin_amdgcn_fence(__ATOMIC_ACQUIRE, "agent");
            xb_add(&bar[XB_XGEN(b.x)], 1u);
            asm volatile("s_waitcnt vmcnt(0)" ::: "memory");
        } else {
            XB_SPIN(xb_ld(&bar[XB_XGEN(b.x)]) == gen, bar);
            __builtin_amdgcn_fence(__ATOMIC_ACQUIRE, "agent");
            asm volatile("s_waitcnt vmcnt(0)" ::: "memory");
        }
    }
    __syncthreads();
}

struct Frame {
    LAS unsigned char* lds; int tid, lane, wave, G, c, gw;
    const float* const* in; float* out; unsigned char* ws;
};
#define WSP(T, off) ((T*)(F.ws + (off)))

__device__ __forceinline__ void tr_tile(const Frame& F, const float* __restrict__ src, int ldn, int k0, int n0, bf16_t* __restrict__ dst, size_t dld, int drow0, int dcol0) {
    LAS float* tile = (LAS float*)F.lds;
    const int tid = F.tid;
#pragma unroll
    for (int i = 0; i < 2; ++i) { const int r = (tid >> 4) + 32 * i, c4 = (tid & 15) * 4; const f32x4 v = *(const f32x4*)(src + (size_t)(k0 + r) * ldn + n0 + c4);
        tile[r * 65 + c4 + 0] = v[0]; tile[r * 65 + c4 + 1] = v[1]; tile[r * 65 + c4 + 2] = v[2]; tile[r * 65 + c4 + 3] = v[3]; }
    __syncthreads();
    { const int n = tid >> 3, kc = (tid & 7) * 8; float f[8];
#pragma unroll
      for (int e = 0; e < 8; ++e) f[e] = tile[(kc + e) * 65 + n];
      u32x4 w; w.x = pk2(f[0], f[1]); w.y = pk2(f[2], f[3]); w.z = pk2(f[4], f[5]); w.w = pk2(f[6], f[7]);
      *(u32x4*)(dst + (size_t)(drow0 + n) * dld + dcol0 + kc) = w; }
    __syncthreads();
}
template <int KIND>
__device__ __forceinline__ void tr_matrix(const Frame& F, const float* __restrict__ src, int K, int N, bf16_t* __restrict__ dst, size_t dld, int dcol_base, int rot) {
    const int nk = K / 64, nn = N / 64, ntile = nk * nn;
    for (int t = (F.c + rot) % F.G; t < ntile; t += F.G) {
        const int kt = t % nk, ntl = t / nk, k0 = kt * 64, n0 = ntl * 64; int drow0 = n0;
        if (KIND == 1) drow0 = n0 + (n0 >= RC ? 64 : 0);
        if (KIND == 2) { const int f = n0 < DFF ? n0 : n0 - DFF; drow0 = 256 * (f >> 7) + (f & 127) + (n0 < DFF ? 0 : 128); }
        tr_tile(F, src, N, k0, n0, dst, dld, drow0, dcol_base + k0);
    }
}
__device__ __forceinline__ void ph_prep(const Frame& F) {
    const size_t gt = (size_t)F.c * NTHR + F.tid, gs = (size_t)F.G * NTHR;
    int rot = 0;
    for (int l = 0; l < NL; ++l) {
        tr_matrix<1>(F, F.in[10] + (size_t)l * DM * INC, DM, INC, WSP(bf16_t, WS_WIN) + (size_t)l * NPJ * DM, DM, 0, rot); rot += 32 * 215;
        for (int br = 0; br < 4; ++br) { tr_matrix<0>(F, F.in[31] + (size_t)(l * 4 + br) * 512 * DM, 512, DM, WSP(bf16_t, WS_WBR) + (size_t)l * DM * DM, DM, br * 512, rot); rot += 8 * 32; }
        tr_matrix<0>(F, F.in[32] + (size_t)l * DM * DM, DM, DM, WSP(bf16_t, WS_WOUT) + (size_t)l * DM * DM, DM, 0, rot); rot += 32 * 32;
        tr_matrix<2>(F, F.in[33] + (size_t)l * DM * 2 * DFF, DM, 2 * DFF, WSP(bf16_t, WS_WFI) + (size_t)l * 2 * DFF * DM, DM, 0, rot); rot += 32 * 176;
        tr_matrix<0>(F, F.in[34] + (size_t)l * DFF * DM, DFF, DM, WSP(bf16_t, WS_WFO) + (size_t)l * DM * DFF, DFF, 0, rot); rot += 88 * 32;
    }
    { bf16_t* w2t = WSP(bf16_t, WS_W2T); bf16_t* a2t = WSP(bf16_t, WS_A2T); bf16_t* g2t = WSP(bf16_t, WS_G2T);
      for (size_t i = gt; i < (size_t)NL * 512 * 96; i += gs) { const int k = (int)(i % 96), n = (int)((i / 96) % 512), l = (int)(i / (96 * 512));
          w2t[i] = (bf16_t)(pk2(F.in[13][((size_t)l * 96 + k) * 512 + n], 0.f) & 0xffffu); a2t[i] = (bf16_t)(pk2(F.in[15][((size_t)l * 96 + k) * 512 + n], 0.f) & 0xffffu); }
      for (size_t i = gt; i < (size_t)NL * 512 * 256; i += gs) { const int k = (int)(i % 256), n = (int)((i / 256) % 512), l = (int)(i / (256 * 512));
          g2t[i] = (bf16_t)(pk2(F.in[16][((size_t)l * 256 + k) * 512 + n], 0.f) & 0xffffu); } }
    { bf16_t* wsb = WSP(bf16_t, WS_WSB);
      for (size_t i = gt; i < (size_t)NL * 8 * 128 * 128; i += gs) { const int j = (int)(i & 127), ii = (int)((i >> 7) & 127); wsb[i] = (bf16_t)(pk2(j <= ii ? F.in[24][i] : 0.f, 0.f) & 0xffffu); } }
    { u32x2* ck = WSP(u32x2, WS_CK); u32x2* cv = WSP(u32x2, WS_CVV); const f32x4* sk = (const f32x4*)F.in[5]; const f32x4* sv = (const f32x4*)F.in[6];
      for (size_t i = gt; i < (size_t)NL * SB * 512 * 512 / 4; i += gs) { const f32x4 a = sk[i], b = sv[i]; u32x2 wa, wb; wa.x = pk2(a[0], a[1]); wa.y = pk2(a[2], a[3]); wb.x = pk2(b[0], b[1]); wb.y = pk2(b[2], b[3]); ck[i] = wa; cv[i] = wb; } }
    { bf16_t* shs = WSP(bf16_t, WS_SHS);
      for (size_t i = gt; i < (size_t)NL * SB * 2048; i += gs) { const int cc = (int)(i & 2047); const size_t lb = i >> 11; shs[i] = cc < RC ? (bf16_t)(pk2(F.in[2][lb * RC + cc], 0.f) & 0xffffu) : (bf16_t)0; }
      bf16_t* zr = WSP(bf16_t, WS_ZROW); for (size_t i = gt; i < 2048; i += gs) zr[i] = (bf16_t)0; }
    { u32x4* z = WSP(u32x4, WS_WIN);
      for (size_t i = gt; i < (size_t)NL * 64 * DM * 2 / 16; i += gs) { const size_t l = i / (64 * DM * 2 / 16), r = i % (64 * DM * 2 / 16); z[(l * NPJ * DM * 2 + (size_t)RC * DM * 2) / 16 + r] = (u32x4){0u, 0u, 0u, 0u}; }
      u32x4* oc = (u32x4*)(F.ws + WS_OCAT + (size_t)MR * DM * 2);
      for (size_t i = gt; i < (size_t)(MP - MR) * DM * 2 / 16; i += gs) oc[i] = (u32x4){0u, 0u, 0u, 0u}; }
}

template <bool FINAL>
__device__ __forceinline__ void ph_rmsnorm(const Frame& F, const float* __restrict__ g, const bool from_inputs) {
    bf16_t* H = WSP(bf16_t, WS_H); bf16_t* XB = WSP(bf16_t, WS_X);
    const int nrow = FINAL ? MR : MP;
    for (int row = F.gw; row < nrow; row += F.G * NWAVE) {
        if (!FINAL && row >= MR) {
#pragma unroll
            for (int i = 0; i < 8; ++i) *(u32x2*)(H + (size_t)row * DM + i * 256 + F.lane * 4) = (u32x2){0u, 0u};
            continue; }
        f32x4 v[8]; float ss = 0.f;
        if (from_inputs) {
            const float* X = row < NPR ? F.in[0] : F.in[1] - (size_t)NPR * DM;
#pragma unroll
            for (int i = 0; i < 8; ++i) v[i] = *(const f32x4*)(X + (size_t)row * DM + i * 256 + F.lane * 4);
#pragma unroll
            for (int i = 0; i < 8; ++i) { u32x2 w; w.x = pk2(v[i][0], v[i][1]); w.y = pk2(v[i][2], v[i][3]); *(u32x2*)(XB + (size_t)row * DM + i * 256 + F.lane * 4) = w; }
        } else {
            u32x2 xr[8];
#pragma unroll
            for (int i = 0; i < 8; ++i) xr[i] = *(const u32x2*)(XB + (size_t)row * DM + i * 256 + F.lane * 4);
#pragma unroll
            for (int i = 0; i < 8; ++i) v[i] = (f32x4){bflo(xr[i].x), bfhi(xr[i].x), bflo(xr[i].y), bfhi(xr[i].y)};
        }
#pragma unroll
        for (int i = 0; i < 8; ++i) ss += v[i][0] * v[i][0] + v[i][1] * v[i][1] + v[i][2] * v[i][2] + v[i][3] * v[i][3];
        ss = wave_sum(ss);
        const float sc = __builtin_amdgcn_rsqf(ss * (1.0f / DM) + 1e-6f);
#pragma unroll
        for (int i = 0; i < 8; ++i) { const f32x4 gg = *(const f32x4*)(g + i * 256 + F.lane * 4); const f32x4 o = v[i] * sc * gg;
            if (FINAL) { float* dst = row < NPR ? F.out + O_YP + (size_t)row * DM : F.out + O_YS + (size_t)(row - NPR) * DM; *(f32x4*)(dst + i * 256 + F.lane * 4) = o; }
            else { u32x2 w; w.x = pk2(o[0], o[1]); w.y = pk2(o[2], o[3]); *(u32x2*)(H + (size_t)row * DM + i * 256 + F.lane * 4) = w; } }
    }
}

struct Sh8 { u32x4 p, q; f32x4 m0, m1; };
__device__ __forceinline__ Sh8 shift8_ld(const bf16_t* prow, const bf16_t* pprev, const float* mu, int col) { Sh8 r; r.p = *(const u32x4*)(prow + col); r.q = *(const u32x4*)(pprev + col); r.m0 = *(const f32x4*)(mu + col); r.m1 = *(const f32x4*)(mu + col + 4); return r; }
__device__ __forceinline__ void shift8_do(const Sh8& r, float (&xs)[8]) {
    float p[8], q[8]; unpack8(r.p, p); unpack8(r.q, q);
#pragma unroll
    for (int e = 0; e < 4; ++e) { xs[e] = p[e] + r.m0[e] * (q[e] - p[e]); xs[4 + e] = p[4 + e] + r.m1[e] * (q[4 + e] - p[4 + e]); }
}
__device__ __forceinline__ void shift8(const bf16_t* prow, const bf16_t* pprev, const float* mu, int col, float (&xs)[8]) {
    float p[8], q[8]; unpack8(*(const u32x4*)(prow + col), p); unpack8(*(const u32x4*)(pprev + col), q);
    const f32x4 m0 = *(const f32x4*)(mu + col), m1 = *(const f32x4*)(mu + col + 4);
#pragma unroll
    for (int e = 0; e < 4; ++e) { xs[e] = p[e] + m0[e] * (q[e] - p[e]); xs[4 + e] = p[4 + e] + m1[e] * (q[4 + e] - p[4 + e]); }
}
__device__ __forceinline__ void shift4(const bf16_t* prow, const bf16_t* pprev, const float* mu, int col, float (&xs)[4]) {
    const u32x2 w = *(const u32x2*)(prow + col), z = *(const u32x2*)(pprev + col); const float p[4] = {bflo(w.x), bfhi(w.x), bflo(w.y), bfhi(w.y)}, q[4] = {bflo(z.x), bfhi(z.x), bflo(z.y), bfhi(z.y)};
    const f32x4 m = *(const f32x4*)(mu + col);
#pragma unroll
    for (int e = 0; e < 4; ++e) xs[e] = p[e] + m[e] * (q[e] - p[e]);
}
__device__ __forceinline__ bf16x8 pack_frag(const float (&f)[8]) { u32x4 w; w.x = pk2(f[0], f[1]); w.y = pk2(f[2], f[3]); w.z = pk2(f[4], f[5]); w.w = pk2(f[6], f[7]); return __builtin_bit_cast(bf16x8, w); }

__device__ __forceinline__ void rwkv_prep_unit(const Frame& F, int l, int tt, int hd_lo, int nh) {
    asm volatile("s_waitcnt vmcnt(0)" ::: "memory");
    int lane = F.lane;
    asm volatile("" : "+v"(lane));
    const int c16 = lane & 15, qd = lane >> 4;
    const int tok = tt * 16 + c16;
    const bf16_t* PJ = WSP(bf16_t, WS_PROJ);
    const bf16_t* prow = PJ + (size_t)tok * NPJ;
    const bool first = tok < NPR ? (tok % SEQ == 0) : ((tok - NPR) % ST == 0);
    const bf16_t* pprev = !first ? prow - NPJ : (tok >= NPR ? WSP(bf16_t, WS_SHS) + ((size_t)l * SB + (tok - NPR) / ST) * 2048 : WSP(bf16_t, WS_ZROW));
    const float* mu = F.in[11] + (size_t)l * RC;
    bf16x8 fw[3], fa[3];
    { Sh8 lw[3], la[3];
#pragma unroll
      for (int ks = 0; ks < 3; ++ks) { lw[ks] = shift8_ld(prow, pprev, mu, 1536 + 32 * ks + 8 * qd); la[ks] = shift8_ld(prow, pprev, mu, 1632 + 32 * ks + 8 * qd); }
      __builtin_amdgcn_sched_barrier(0);
#pragma unroll
      for (int ks = 0; ks < 3; ++ks) { float xs[8]; shift8_do(lw[ks], xs);
#pragma unroll
          for (int e = 0; e < 8; ++e) xs[e] = ftanh(xs[e]);
          fw[ks] = pack_frag(xs); shift8_do(la[ks], xs); fa[ks] = pack_frag(xs); } }
    __builtin_amdgcn_sched_barrier(0);
    const bf16_t* W2T = WSP(bf16_t, WS_W2T) + (size_t)l * 512 * 96; const bf16_t* A2T = WSP(bf16_t, WS_A2T) + (size_t)l * 512 * 96;
    const float* w0 = F.in[12] + l * 512; const float* a0 = F.in[14] + l * 512; const float* kkw = F.in[17] + l * 512; const float* kaw = F.in[18] + l * 512; const float* rkw = F.in[19] + l * 512;
    bf16_t* SV = (bf16_t*)(WSP(float, WS_SCAN) + 3 * (size_t)MR * 512);
    float* BON = WSP(float, WS_BON);
    LAS unsigned char* wl = F.lds + F.wave * 8192;
#define DPP_SHR1(x, n) __int_as_float(__builtin_amdgcn_update_dpp(0x3f800000, __float_as_int(x), 0x110 + (n), 0xF, 0xF, false))
#pragma unroll 1
    for (int hd = hd_lo; hd < hd_lo + nh; ++hd) {
        asm volatile("s_waitcnt vmcnt(0)" ::: "memory");
        int lq = lane; asm volatile("" : "+v"(lq));
        const int c16h = lq & 15, qdh = lq >> 4;
        unsigned char* rec = F.ws + WS_REC + ((size_t)tt * 8 + hd) * REC_BYTES + (size_t)lq * 16;
        float ss = 0.f, bon = 0.f;
        bf16x8 pbw[3], pba[3]; u32x2 ppc[3], ppq[3];
#define RW_ISSUE(nt_) do { const int n_ = hd * 64 + (nt_) * 16 + c16h, col_ = hd * 64 + (nt_) * 16 + 4 * qdh; \
            _Pragma("unroll") for (int k3 = 0; k3 < 3; ++k3) { pbw[k3] = *(const bf16x8*)(W2T + (size_t)n_ * 96 + 32 * k3 + 8 * qdh); pba[k3] = *(const bf16x8*)(A2T + (size_t)n_ * 96 + 32 * k3 + 8 * qdh); } \
            _Pragma("unroll") for (int sg = 0; sg < 3; ++sg) { ppc[sg] = *(const u32x2*)(prow + sg * 512 + col_); ppq[sg] = *(const u32x2*)(pprev + sg * 512 + col_); } } while (0)
        { u32x2 kc[4], kq[4]; f32x4 mk[4], kw4[4];
#pragma unroll
          for (int nt = 0; nt < 4; ++nt) { const int col = hd * 64 + nt * 16 + 4 * qdh; kc[nt] = *(const u32x2*)(prow + 512 + col); kq[nt] = *(const u32x2*)(pprev + 512 + col); mk[nt] = *(const f32x4*)(mu + 512 + col); kw4[nt] = *(const f32x4*)(kkw + col); }
          RW_ISSUE(0);
          __builtin_amdgcn_sched_barrier(0);
#pragma unroll
          for (int nt = 0; nt < 4; ++nt) { const float p[4] = {bflo(kc[nt].x), bfhi(kc[nt].x), bflo(kc[nt].y), bfhi(kc[nt].y)}, q[4] = {bflo(kq[nt].x), bfhi(kq[nt].x), bflo(kq[nt].y), bfhi(kq[nt].y)};
#pragma unroll
              for (int j = 0; j < 4; ++j) { const float kx = (p[j] + mk[nt][j] * (q[j] - p[j])) * kw4[nt][j]; ss += kx * kx; } } }
        ss += __shfl_xor(ss, 16); ss += __shfl_xor(ss, 32);
        const float inv = __builtin_amdgcn_rsqf(fmaxf(ss, 1e-24f));
        __builtin_amdgcn_sched_barrier(0);
        f32x4 Lb = (f32x4){0.f, 0.f, 0.f, 0.f}, Lk = Lb, Mb = Lb, Mk = Lb;
#pragma unroll
        for (int ks = 0; ks < 2; ++ks) {
            float rr[2][4], ww[2][4], km[2][4], aa[2][4], bb[2][4];
#pragma unroll
            for (int n2 = 0; n2 < 2; ++n2) { const int nt = 2 * ks + n2;
                f32x4 accw = (f32x4){0.f, 0.f, 0.f, 0.f}, acca = accw;
                const int n = hd * 64 + nt * 16 + c16h;
                const int col = hd * 64 + nt * 16 + 4 * qdh;
                bf16x8 bw[3], ba[3]; u32x2 pcn[3], pqn[3];
#pragma unroll
                for (int k3 = 0; k3 < 3; ++k3) { bw[k3] = pbw[k3]; ba[k3] = pba[k3]; pcn[k3] = ppc[k3]; pqn[k3] = ppq[k3]; }
                const f32x4 m0 = *(const f32x4*)(mu + col), m1 = *(const f32x4*)(mu + 512 + col), m2 = *(const f32x4*)(mu + 1024 + col);
                const f32x4 w0v = *(const f32x4*)(w0 + col), a0v = *(const f32x4*)(a0 + col), kkv = *(const f32x4*)(kkw + col), kav = *(const f32x4*)(kaw + col), rkv = *(const f32x4*)(rkw + col);
                if (nt < 3) RW_ISSUE(nt + 1);
                __builtin_amdgcn_sched_barrier(0);
#pragma unroll
                for (int k3 = 0; k3 < 3; ++k3) { accw = __builtin_amdgcn_mfma_f32_16x16x32_bf16(bw[k3], fw[k3], accw, 0, 0, 0); acca = __builtin_amdgcn_mfma_f32_16x16x32_bf16(ba[k3], fa[k3], acca, 0, 0, 0); }
                float vvn[4];
                { const u32x2 a = pcn[0], b = pqn[0], c = pcn[1], d = pqn[1], e = pcn[2], f = pqn[2];
                  const float p0[4] = {bflo(a.x), bfhi(a.x), bflo(a.y), bfhi(a.y)}, q0[4] = {bflo(b.x), bfhi(b.x), bflo(b.y), bfhi(b.y)};
                  const float p1[4] = {bflo(c.x), bfhi(c.x), bflo(c.y), bfhi(c.y)}, q1[4] = {bflo(d.x), bfhi(d.x), bflo(d.y), bfhi(d.y)};
                  const float p2[4] = {bflo(e.x), bfhi(e.x), bflo(e.y), bfhi(e.y)}, q2[4] = {bflo(f.x), bfhi(f.x), bflo(f.y), bfhi(f.y)};
#pragma unroll
                  for (int j = 0; j < 4; ++j) { rr[n2][j] = p0[j] + m0[j] * (q0[j] - p0[j]); km[n2][j] = p1[j] + m1[j] * (q1[j] - p1[j]); vvn[j] = p2[j] + m2[j] * (q2[j] - p2[j]); } }
#pragma unroll
                for (int j = 0; j < 4; ++j) { ww[n2][j] = fexp(-0.60653065971f * sigm(w0v[j] + accw[j])); const float asig = sigm(a0v[j] + acca[j]);
                    const float k = km[n2][j], kn = k * kkv[j] * inv; aa[n2][j] = -kn; bb[n2][j] = kn * asig;
                    const float kmod = k * (1.0f + (asig - 1.0f) * kav[j]); km[n2][j] = kmod; bon += rr[n2][j] * kmod * rkv[j]; }
                { u32x2 wv; wv.x = pk2(vvn[0], vvn[1]); wv.y = pk2(vvn[2], vvn[3]); *(u32x2*)(SV + (size_t)tok * 512 + col) = wv; }
#pragma unroll
                for (int j = 0; j < 4; ++j) *(LAS bf16_t*)(wl + 5120 + (16 * nt + 4 * qdh + j) * 40 + c16h * 2) = (bf16_t)(pk2(vvn[j], 0.f) & 0xffffu);
                __builtin_amdgcn_sched_barrier(0);
            }
#pragma unroll
            for (int n2 = 0; n2 < 2; ++n2) { const int nt = 2 * ks + n2;
#pragma unroll
                for (int j = 0; j < 4; ++j) {
                    float g = ww[n2][j];
                    g *= DPP_SHR1(g, 1); g *= DPP_SHR1(g, 2); g *= DPP_SHR1(g, 4); g *= DPP_SHR1(g, 8);
                    const float gex = DPP_SHR1(g, 1), gi = frcp(g);
                    ww[n2][j] = g;
                    aa[n2][j] *= gex;
                    bb[n2][j] *= gi;
                    km[n2][j] *= gi;
                    rr[n2][j] *= g;
                    const int key = 16 * nt + 4 * qdh + j; const unsigned pb = pk2(bb[n2][j], km[n2][j]);
                    *(LAS bf16_t*)(wl + key * 40 + c16h * 2) = (bf16_t)(pb & 0xffffu); *(LAS bf16_t*)(wl + 2560 + key * 40 + c16h * 2) = (bf16_t)(pb >> 16);
                }
                if (c16h == 15) *(f32x4*)(rec - (size_t)lq * 16 + REC_G16 + (16 * nt + 4 * qdh) * 4) = (f32x4){ww[n2][0], ww[n2][1], ww[n2][2], ww[n2][3]};
            }
            const float xa[8] = {aa[0][0], aa[0][1], aa[0][2], aa[0][3], aa[1][0], aa[1][1], aa[1][2], aa[1][3]};
            const float xr[8] = {rr[0][0], rr[0][1], rr[0][2], rr[0][3], rr[1][0], rr[1][1], rr[1][2], rr[1][3]};
            const float xb[8] = {bb[0][0], bb[0][1], bb[0][2], bb[0][3], bb[1][0], bb[1][1], bb[1][2], bb[1][3]};
            const float xk[8] = {km[0][0], km[0][1], km[0][2], km[0][3], km[1][0], km[1][1], km[1][2], km[1][3]};
            const bf16x8 fA = pack_frag(xa), fR = pack_frag(xr), fB = pack_frag(xb), fK = pack_frag(xk);
            *(bf16x8*)(rec + (0 + ks) * 1024) = fA; *(bf16x8*)(rec + (2 + ks) * 1024) = fR;
            Lb = __builtin_amdgcn_mfma_f32_16x16x32_bf16(fB, fA, Lb, 0, 0, 0); Lk = __builtin_amdgcn_mfma_f32_16x16x32_bf16(fK, fA, Lk, 0, 0, 0);
            Mb = __builtin_amdgcn_mfma_f32_16x16x32_bf16(fB, fR, Mb, 0, 0, 0); Mk = __builtin_amdgcn_mfma_f32_16x16x32_bf16(fK, fR, Mk, 0, 0, 0);
            __builtin_amdgcn_sched_barrier(0);
        }
        bon += __shfl_xor(bon, 16); bon += __shfl_xor(bon, 32);
        if (qdh == 0) BON[(size_t)tok * 8 + hd] = bon;
#pragma unroll
        for (int j = 0; j < 4; ++j) { const int sidx = 4 * qdh + j; if (!(sidx < c16h)) { Lb[j] = 0.f; Lk[j] = 0.f; } if (!(sidx <= c16h)) { Mb[j] = 0.f; Mk[j] = 0.f; } }
        { const float xl[8] = {Lk[0], Lk[1], Lk[2], Lk[3], 0.f, 0.f, 0.f, 0.f}; *(bf16x8*)(rec + 4 * 1024) = pack_frag(xl);
          const float xm[8] = {Mb[0], Mb[1], Mb[2], Mb[3], Mk[0], Mk[1], Mk[2], Mk[3]}; *(bf16x8*)(rec + 6 * 1024) = pack_frag(xm); }
        { float Lf[16], Tc[16];
#pragma unroll
          for (int f = 0; f < 4; ++f)
#pragma unroll
              for (int j = 0; j < 4; ++j) Lf[4 * f + j] = __shfl(Lb[j], c16h + 16 * f);
#pragma unroll
          for (int sI = 0; sI < 16; ++sI) Tc[sI] = (sI == c16h) ? 1.0f : 0.0f;
#pragma unroll
          for (int m = 0; m < 15; ++m) {
#pragma unroll
              for (int sI = 0; sI <= m; ++sI) Tc[sI] += __int_as_float(__builtin_amdgcn_readlane(__float_as_int(Tc[sI]), m)) * Lf[m]; }
          float xt[8];
#pragma unroll
          for (int e = 0; e < 4; ++e) { xt[e] = qdh == 0 ? Tc[e] : qdh == 1 ? Tc[4 + e] : qdh == 2 ? Tc[8 + e] : Tc[12 + e]; xt[4 + e] = 0.f; }
          *(bf16x8*)(rec + 5 * 1024) = pack_frag(xt); }
        asm volatile("s_waitcnt lgkmcnt(0)" ::: "memory");
#pragma unroll
        for (int kt = 0; kt < 4; ++kt) { const int rowo = (16 * kt + c16h) * 40 + 8 * qdh;
            const u32x2 b4 = *(const LAS u32x2*)(wl + rowo), k4 = *(const LAS u32x2*)(wl + 2560 + rowo), v4 = *(const LAS u32x2*)(wl + 5120 + rowo);
            *(u32x4*)(rec + (7 + kt) * 1024) = (u32x4){b4.x, b4.y, k4.x, k4.y};
            *(u32x2*)(rec - (size_t)lq * 8 + REC_FV + kt * 512) = v4; }
        asm volatile("s_waitcnt lgkmcnt(0)" ::: "memory");
    }
#undef DPP_SHR1
#undef RW_ISSUE
}

__device__ __forceinline__ void rwkv_gate_unit(const Frame& F, int l, int tt, int t_lo, int nt16) {
    asm volatile("s_waitcnt vmcnt(0)" ::: "memory");
    int lane = F.lane;
    asm volatile("" : "+v"(lane));
    const int c16 = lane & 15, qd = lane >> 4;
    const int tok = tt * 16 + c16;
    const bf16_t* prow = WSP(bf16_t, WS_PROJ) + (size_t)tok * NPJ;
    const bool first = tok < NPR ? (tok % SEQ == 0) : ((tok - NPR) % ST == 0);
    const bf16_t* pprev = !first ? prow - NPJ : (tok >= NPR ? WSP(bf16_t, WS_SHS) + ((size_t)l * SB + (tok - NPR) / ST) * 2048 : WSP(bf16_t, WS_ZROW));
    const float* mu = F.in[11] + (size_t)l * RC;
    bf16x8 fg[8];
#pragma unroll
    for (int hb = 0; hb < 2; ++hb) { Sh8 lg[4];
#pragma unroll
      for (int ks = 0; ks < 4; ++ks) lg[ks] = shift8_ld(prow, pprev, mu, 1728 + 32 * (4 * hb + ks) + 8 * qd);
      __builtin_amdgcn_sched_barrier(0); asm volatile("s_waitcnt vmcnt(0)" ::: "memory"); __builtin_amdgcn_sched_barrier(0);
#pragma unroll
      for (int ks = 0; ks < 4; ++ks) { float xs[8]; shift8_do(lg[ks], xs);
#pragma unroll
          for (int e = 0; e < 8; ++e) xs[e] = sigm(xs[e]);
          fg[4 * hb + ks] = pack_frag(xs); }
      __builtin_amdgcn_sched_barrier(0); }
    const bf16_t* G2T = WSP(bf16_t, WS_G2T) + (size_t)l * 512 * 256; bf16_t* GG = WSP(bf16_t, WS_G);
    for (int t16 = t_lo; t16 < t_lo + nt16; t16 += 4) {
        f32x4 accg[4]; bf16x8 bg[4][8];
#pragma unroll
        for (int u = 0; u < 4; ++u) { accg[u] = (f32x4){0.f, 0.f, 0.f, 0.f}; const int n = (t16 + u) * 16 + c16;
#pragma unroll
            for (int ks = 0; ks < 8; ++ks) bg[u][ks] = *(const bf16x8*)(G2T + (size_t)n * 256 + 32 * ks + 8 * qd); }
        __builtin_amdgcn_sched_barrier(0); asm volatile("s_waitcnt vmcnt(0)" ::: "memory"); __builtin_amdgcn_sched_barrier(0);
#pragma unroll
        for (int u = 0; u < 4; ++u)
#pragma unroll
            for (int ks = 0; ks < 8; ++ks) accg[u] = __builtin_amdgcn_mfma_f32_16x16x32_bf16(bg[u][ks], fg[ks], accg[u], 0, 0, 0);
        __builtin_amdgcn_sched_barrier(0);
#pragma unroll
        for (int u = 0; u < 4; ++u) { u32x2 wg; wg.x = pk2(accg[u][0], accg[u][1]); wg.y = pk2(accg[u][2], accg[u][3]); *(u32x2*)(GG + (size_t)tok * 512 + (t16 + u) * 16 + 4 * qd) = wg; }
        __builtin_amdgcn_sched_barrier(0);
    }
}

constexpr int GV_PITCH = 1040;
__device__ __forceinline__ void gmlp_unit(const Frame& F, int l, int unit) {
    asm volatile("s_waitcnt vmcnt(0)" ::: "memory");
    const int lane = F.lane, w = F.wave, c16 = lane & 15, qd = lane >> 4;
    const bool samp = unit >= 128; const int tokbase = samp ? NPR + (unit - 128) * ST : unit * 128, ntok = samp ? ST : 128;
    const bf16_t* PJ = WSP(bf16_t, WS_PROJ);
    const float* lnw = F.in[22] + l * 512; const float* lnb = F.in[23] + l * 512;
    LAS unsigned char* vimg = F.lds;
    { const f32x4 g0 = *(const f32x4*)(lnw + lane * 8), g1 = *(const f32x4*)(lnw + lane * 8 + 4), b0 = *(const f32x4*)(lnb + lane * 8), b1 = *(const f32x4*)(lnb + lane * 8 + 4);
      for (int t4 = w * 16; t4 < w * 16 + 16; t4 += 4) {
        if (t4 < ntok) {
            u32x4 raw[4];
#pragma unroll
            for (int u = 0; u < 4; ++u) raw[u] = *(const u32x4*)(PJ + (size_t)(tokbase + t4 + u) * NPJ + GM_OFF + 512 + lane * 8);
            __builtin_amdgcn_sched_barrier(0);
#pragma unroll
            for (int u = 0; u < 4; ++u) { const int tl = t4 + u;
                float x[8]; unpack8(raw[u], x); float s = 0.f;
#pragma unroll
                for (int e = 0; e < 8; ++e) { x[e] = gelu_t(x[e]); s += x[e]; }
                const float mean = wave_sum(s) * (1.0f / 512.0f); float q = 0.f;
#pragma unroll
                for (int e = 0; e < 8; ++e) { x[e] -= mean; q += x[e] * x[e]; }
                const float rstd = __builtin_amdgcn_rsqf(wave_sum(q) * (1.0f / 512.0f) + 1e-5f);
#pragma unroll
                for (int e = 0; e < 4; ++e) { x[e] = x[e] * rstd * g0[e] + b0[e]; x[4 + e] = x[4 + e] * rstd * g1[e] + b1[e]; }
                u32x4 pk; pk.x = pk2(x[0], x[1]); pk.y = pk2(x[2], x[3]); pk.z = pk2(x[4], x[5]); pk.w = pk2(x[6], x[7]);
                *(LAS u32x4*)(vimg + tl * GV_PITCH + lane * 16) = pk;
                if (samp) { float* o = F.out + O_SGV + (((size_t)l * SB + (unit - 128)) * ST + tl) * 512 + lane * 8; *(f32x4*)o = (f32x4){x[0], x[1], x[2], x[3]}; *(f32x4*)(o + 4) = (f32x4){x[4], x[5], x[6], x[7]}; } }
        } else if (t4 < 32) {
#pragma unroll
            for (int u = 0; u < 4; ++u) *(LAS u32x4*)(vimg + (t4 + u) * GV_PITCH + lane * 16) = (u32x4){0u, 0u, 0u, 0u}; }
      } }
    __syncthreads();
    { const int g = w; const bf16_t* W = WSP(bf16_t, WS_WSB) + ((size_t)l * 8 + g) * 128 * 128; const float* bs = F.in[25] + ((size_t)l * 8 + g) * 128;
      const int nks = samp ? 1 : 4, nit = samp ? 1 : 8;
      bf16x8 vf[4][4];
#pragma unroll
      for (int ks = 0; ks < 4; ++ks)
#pragma unroll
          for (int dt = 0; dt < 4; ++dt) { LAS unsigned char* a = vimg + (32 * ks + 8 * qd + (c16 >> 2)) * GV_PITCH + (g * 64 + 16 * dt + 4 * (c16 & 3)) * 2;
              vf[ks][dt] = cat8(lds_tr(a), lds_tr(a + 4 * GV_PITCH)); }
      for (int it = 0; it < nit; ++it) {
          f32x4 acc[4];
#pragma unroll
          for (int dt = 0; dt < 4; ++dt) acc[dt] = (f32x4){0.f, 0.f, 0.f, 0.f};
#pragma unroll
          for (int ks = 0; ks < 4; ++ks) if (ks < nks && ks <= (it >> 1)) { const bf16x8 wf = *(const bf16x8*)(W + (size_t)(16 * it + c16) * 128 + 32 * ks + 8 * qd);
#pragma unroll
              for (int dt = 0; dt < 4; ++dt) acc[dt] = __builtin_amdgcn_mfma_f32_16x16x32_bf16(vf[ks][dt], wf, acc[dt], 0, 0, 0); }
          const int tok = tokbase + 16 * it + c16; const float bsv = bs[16 * it + c16];
#pragma unroll
          for (int dt = 0; dt < 4; ++dt) { const int ch = g * 64 + 16 * dt + 4 * qd; const u32x2 uw = *(const u32x2*)(PJ + (size_t)tok * NPJ + GM_OFF + ch);
              const float u0 = gelu_t(bflo(uw.x)), u1 = gelu_t(bfhi(uw.x)), u2 = gelu_t(bflo(uw.y)), u3 = gelu_t(bfhi(uw.y));
              u32x2 o; o.x = pk2(u0 * (acc[dt][0] + bsv), u1 * (acc[dt][1] + bsv)); o.y = pk2(u2 * (acc[dt][2] + bsv), u3 * (acc[dt][3] + bsv));
              *(u32x2*)(WSP(bf16_t, WS_OCAT) + (size_t)tok * DM + 512 + ch) = o; }
      } }
    __syncthreads();
}

__device__ __forceinline__ void conv_unit(const Frame& F, int l, int unit) {
    const int c = F.tid, lane = F.lane, w = F.wave;
    const bool samp = unit >= 256; const int b = samp ? unit - 256 : unit >> 5, t0 = samp ? 0 : (unit & 31) * 64, nsub = samp ? 1 : 4;
    const int tokbase = samp ? NPR + b * ST : b * SEQ;
    const bf16_t* PJ = WSP(bf16_t, WS_PROJ) + CV_OFF;
    LAS float* ybuf = (LAS float*)F.lds;
    LAS float* stats = (LAS float*)(F.lds + 32768);
    float dw[31];
#pragma unroll
    for (int k = 0; k < 31; ++k) dw[k] = F.in[26][((size_t)l * 31 + k) * 512 + c];
    const float bias = F.in[27][l * 512 + c], lw = F.in[28][l * 512 + c], lb = F.in[29][l * 512 + c];
    float win[46];
    asm volatile("s_waitcnt vmcnt(0)" ::: "memory");
    if (samp) {
#pragma unroll
        for (int j = 0; j < 30; ++j) win[j] = F.in[4][(((size_t)l * SB + b) * 30 + j) * 512 + c];
    } else if (t0 > 0) {
#pragma unroll
        for (int hb = 0; hb < 2; ++hb) { bf16_t hv[15], hg[15];
#pragma unroll
            for (int j = 0; j < 15; ++j) { const bf16_t* pr = PJ + (size_t)(tokbase + t0 - 30 + 15 * hb + j) * NPJ; hv[j] = pr[c]; hg[j] = pr[512 + c]; }
            __builtin_amdgcn_sched_barrier(0);
#pragma unroll
            for (int j = 0; j < 15; ++j) win[15 * hb + j] = bf1(hv[j]) * sigm(bf1(hg[j]));
            __builtin_amdgcn_sched_barrier(0); }
    } else {
#pragma unroll
        for (int j = 0; j < 30; ++j) win[j] = 0.f;
    }
    __builtin_amdgcn_sched_barrier(0);
    for (int sub = 0; sub < nsub; ++sub) {
        const int tb = tokbase + t0 + sub * 16;
        asm volatile("s_waitcnt vmcnt(0)" ::: "memory");
        { bf16_t zv[16], zg[16];
#pragma unroll
          for (int i = 0; i < 16; ++i) { const bf16_t* pr = PJ + (size_t)(tb + i) * NPJ; zv[i] = pr[c]; zg[i] = pr[512 + c]; }
          __builtin_amdgcn_sched_barrier(0);
#pragma unroll
          for (int i = 0; i < 16; ++i) win[30 + i] = bf1(zv[i]) * sigm(bf1(zg[i])); }
        float y[16];
#pragma unroll
        for (int i = 0; i < 16; ++i) { float a = bias;
#pragma unroll
            for (int k = 0; k < 31; ++k) a += win[i + k] * dw[k];
            y[i] = a; ybuf[i * 512 + c] = a; }
        if (samp || (t0 == SEQ - 64 && sub == 3)) { float* so = F.out + (samp ? O_SCV : O_PCV) + ((size_t)l * 8 + b) * 30 * 512 + c;
#pragma unroll
            for (int j = 0; j < 30; ++j) so[(size_t)j * 512] = win[16 + j]; }
        __syncthreads();
#pragma unroll
        for (int r = 0; r < 2; ++r) { const int i = 2 * w + r; float v[8]; float s = 0.f;
#pragma unroll
            for (int e = 0; e < 8; ++e) { v[e] = ybuf[i * 512 + e * 64 + lane]; s += v[e]; }
            const float mean = wave_sum(s) * (1.0f / 512.0f); float q = 0.f;
#pragma unroll
            for (int e = 0; e < 8; ++e) { const float d = v[e] - mean; q += d * d; }
            const float rstd = __builtin_amdgcn_rsqf(wave_sum(q) * (1.0f / 512.0f) + 1e-5f);
            if (lane == 0) { stats[2 * i] = mean; stats[2 * i + 1] = rstd; } }
        __syncthreads();
#pragma unroll
        for (int i = 0; i < 16; ++i) { const float o = (y[i] - stats[2 * i]) * stats[2 * i + 1] * lw + lb; const float sv = o * sigm(o);
            WSP(bf16_t, WS_OCAT)[(size_t)(tb + i) * DM + 1024 + c] = (bf16_t)(pk2(sv, 0.f) & 0xffffu); }
        __syncthreads();
#pragma unroll
        for (int j = 0; j < 30; ++j) win[j] = win[j + 16];
    }
}

constexpr int AV_PITCH = 144;
__device__ __forceinline__ void attn_ldk(bf16x8 (&kf)[8], const bf16_t* kA, size_t strideA, const bf16_t* kB, size_t strideB, int split, int bc, int g_hi, int c16, int qd) {
#pragma unroll
    for (int kt = 0; kt < 4; ++kt) { int g = bc * 4 + kt; g = g < g_hi ? g : g_hi - 1;
        const bf16_t* kr = g < split ? kA + (size_t)(16 * g + c16) * strideA : kB + (size_t)(16 * (g - split) + c16) * strideB;
        kf[2 * kt] = *(const bf16x8*)(kr + 8 * qd); kf[2 * kt + 1] = *(const bf16x8*)(kr + 32 + 8 * qd); }
}
__device__ __forceinline__ void attn_wave_unit(const Frame& F, const bf16_t* qrowA  , const bf16_t* qrowB, const bf16_t* kA, size_t strideA, const bf16_t* kB, size_t strideB, int split,
                                               int g_lo, int g_hi, int qiA  , int qiB, const LAS float* table  , LAS unsigned char* vimg, int vrow0, bf16_t* orowA, bf16_t* orowB) {
    asm volatile("s_waitcnt vmcnt(0)" ::: "memory");
    const int lane = F.lane, c16 = lane & 15, qd = lane >> 4;
    bf16x8 q0[2], q1[2];
    q0[0] = *(const bf16x8*)(qrowA + 8 * qd); q1[0] = *(const bf16x8*)(qrowA + 32 + 8 * qd); q0[1] = *(const bf16x8*)(qrowB + 8 * qd); q1[1] = *(const bf16x8*)(qrowB + 32 + 8 * qd);
    const int qi[2] = {qiA, qiB};
    float mx[2] = {-1e30f, -1e30f}, sum[2] = {0.f, 0.f};
    const float tconst = table[256];
    f32x4 o[2][4];
#pragma unroll
    for (int t = 0; t < 2; ++t)
#pragma unroll
        for (int dt = 0; dt < 4; ++dt) o[t][dt] = (f32x4){0.f, 0.f, 0.f, 0.f};
    bf16x8 kf[8];
    attn_ldk(kf, kA, strideA, kB, strideB, split, g_lo >> 2, g_hi, c16, qd);
    for (int bc = g_lo >> 2; bc < 9; ++bc) {
        bf16x8 kn[8];
        attn_ldk(kn, kA, strideA, kB, strideB, split, bc + 1 < 9 ? bc + 1 : bc, g_hi, c16, qd);
        f32x4 s[2][4]; float cm[2] = {-1e30f, -1e30f};
#pragma unroll
        for (int kt = 0; kt < 4; ++kt) { const int g = bc * 4 + kt;
#pragma unroll
            for (int t = 0; t < 2; ++t) {
                f32x4 a = (f32x4){0.f, 0.f, 0.f, 0.f};
                a = __builtin_amdgcn_mfma_f32_16x16x32_bf16(kf[2 * kt], q0[t], a, 0, 0, 0); a = __builtin_amdgcn_mfma_f32_16x16x32_bf16(kf[2 * kt + 1], q1[t], a, 0, 0, 0);
#pragma unroll
                for (int e = 0; e < 4; ++e) { float bias = tconst; if (bc >= 6) { const int rel = 512 + qi[t] - (16 * g + 4 * qd + e); bias = table[(rel > 128 ? 128 : rel) + 128]; }
                    a[e] = g < g_hi ? a[e] * 0.125f + bias : -1e30f; cm[t] = fmaxf(cm[t], a[e]); }
                s[t][kt] = a; }
        }
#pragma unroll
        for (int t = 0; t < 2; ++t) {
            float c = cm[t]; c = fmaxf(c, __shfl_xor(c, 16)); c = fmaxf(c, __shfl_xor(c, 32));
            const float mn = fmaxf(mx[t], c), alpha = fexp(mx[t] - mn); mx[t] = mn; sum[t] *= alpha;
#pragma unroll
            for (int dt = 0; dt < 4; ++dt) o[t][dt] *= alpha; }
#pragma unroll
        for (int pp = 0; pp < 2; ++pp) {
            bf16x8 pf[2];
#pragma unroll
            for (int t = 0; t < 2; ++t) { float p[8];
#pragma unroll
                for (int e = 0; e < 4; ++e) { p[e] = fexp(s[t][2 * pp][e] - mx[t]); p[4 + e] = fexp(s[t][2 * pp + 1][e] - mx[t]); sum[t] += p[e] + p[4 + e]; }
                pf[t] = pack_frag(p); }
            LAS unsigned char* a = vimg + (vrow0 + 64 * bc + 32 * pp + 4 * qd + (c16 >> 2)) * AV_PITCH + 8 * (c16 & 3);
#pragma unroll
            for (int dt = 0; dt < 4; ++dt) { const bf16x8 vf = cat8(lds_tr(a + dt * 32), lds_tr(a + 16 * AV_PITCH + dt * 32));
                o[0][dt] = __builtin_amdgcn_mfma_f32_16x16x32_bf16(vf, pf[0], o[0][dt], 0, 0, 0); o[1][dt] = __builtin_amdgcn_mfma_f32_16x16x32_bf16(vf, pf[1], o[1][dt], 0, 0, 0); }
        }
#pragma unroll
        for (int i = 0; i < 8; ++i) kf[i] = kn[i];
    }
#pragma unroll
    for (int t = 0; t < 2; ++t) { float sm = sum[t]; sm += __shfl_xor(sm, 16); sm += __shfl_xor(sm, 32);
        const float inv = frcp(sm); bf16_t* orow = t == 0 ? orowA : orowB;
#pragma unroll
        for (int dt = 0; dt < 4; ++dt) { u32x2 wv; wv.x = pk2(o[t][dt][0] * inv, o[t][dt][1] * inv); wv.y = pk2(o[t][dt][2] * inv, o[t][dt][3] * inv); *(u32x2*)(orow + 16 * dt + 4 * qd) = wv; } }
}
constexpr int ATBL_OFF = 1024 * AV_PITCH;
__device__ __forceinline__ void attn_jobs(const Frame& F, int l) {
    const int lane = F.lane, w = F.wave, c16 = lane & 15;
    const bf16_t* PJ = WSP(bf16_t, WS_PROJ) + AT_OFF; bf16_t* OC = WSP(bf16_t, WS_OCAT) + 1536;
    LAS unsigned char* vimg = F.lds; LAS float* tbl = (LAS float*)(F.lds + ATBL_OFF);
    for (int slot = 0; slot < 2; ++slot) {
        const bool prompt = slot == 0; const int job = prompt ? F.c : F.G - 1 - F.c;
        if (job >= (prompt ? 256 : 64)) continue;
        const int b = prompt ? job >> 5 : job >> 3, h = prompt ? (job >> 2) & 7 : job & 7, seg = job & 3;
        if (F.tid < 257) tbl[F.tid] = F.in[30][((size_t)l * 8 + h) * 257 + F.tid];
        const bf16_t* CK = WSP(bf16_t, WS_CK) + ((size_t)l * SB + b) * 512 * 512 + h * 64; const bf16_t* CV = WSP(bf16_t, WS_CVV) + ((size_t)l * SB + b) * 512 * 512 + h * 64;
        if (prompt) {
            for (int it = 0; it < 16; it += 8) { u32x4 v[8];
#pragma unroll
                for (int j = 0; j < 8; ++j) { const int pc = F.tid + (it + j) * NTHR, row = pc >> 3, part = pc & 7, pos = (8 * seg - 8) * 64 + row;
                    v[j] = *(const u32x4*)(PJ + (size_t)(b * SEQ + (pos < 0 ? 0 : pos)) * NPJ + 1024 + h * 64 + part * 8); }
                __builtin_amdgcn_sched_barrier(0);
#pragma unroll
                for (int j = 0; j < 8; ++j) { const int pc = F.tid + (it + j) * NTHR, row = pc >> 3, part = pc & 7; *(LAS u32x4*)(vimg + row * AV_PITCH + part * 16) = v[j]; }
                __builtin_amdgcn_sched_barrier(0); }
        } else {
            for (int pc = F.tid; pc < 576 * 8; pc += NTHR) { const int row = pc >> 3, part = pc & 7; u32x4 v = (u32x4){0u, 0u, 0u, 0u};
                if (row < 512) v = *(const u32x4*)(CV + (size_t)row * 512 + part * 8); else if (row < 528) v = *(const u32x4*)(PJ + (size_t)(NPR + b * ST + row - 512) * NPJ + 1024 + h * 64 + part * 8);
                *(LAS u32x4*)(vimg + row * AV_PITCH + part * 16) = v; }
        }
        __syncthreads();
        const int nr = prompt ? 2 : 1;
        for (int r = 0; r < nr; ++r) {
            if (prompt || w == 0) {
                const int id = r * 8 + w, qc = id >> 1, qtA = 2 * (id & 1), qtB = prompt ? qtA + 1 : qtA, chunk = 8 * seg + qc;
                const int qtokA = prompt ? b * SEQ + chunk * 64 + qtA * 16 + c16 : NPR + b * ST + c16, qtokB = prompt ? qtokA + 16 : qtokA;
                const int pos0 = chunk * 64 - 512;
                const bf16_t* kA = prompt ? PJ + (ptrdiff_t)(b * SEQ + pos0) * NPJ + 512 + h * 64 : CK;
                const bf16_t* kB = PJ + (size_t)(NPR + b * ST) * NPJ + 512 + h * 64;
                attn_wave_unit(F, PJ + (size_t)qtokA * NPJ + h * 64, PJ + (size_t)qtokB * NPJ + h * 64, kA, prompt ? (size_t)NPJ : (size_t)512, kB, NPJ, prompt ? 36 : 32, prompt ? (pos0 < 0 ? (-pos0) / 16 : 0) : 0, prompt ? 36 : 33,
                               prompt ? qtA * 16 + c16 : c16, prompt ? qtB * 16 + c16 : c16, tbl, vimg, prompt ? qc * 64 : 0, OC + (size_t)qtokA * DM + h * 64, OC + (size_t)qtokB * DM + h * 64);
            }
        }
        __syncthreads();
    }
}

__device__ __forceinline__ void state_copies(const Frame& F, int l) {
    const size_t gt = (size_t)F.c * NTHR + F.tid, gs = (size_t)F.G * NTHR;
    const bf16_t* PJ = WSP(bf16_t, WS_PROJ);
    for (size_t i = gt; i < 16 * 248; i += gs) { const int s = (int)(i / 248), c8 = (int)(i % 248) * 8; const int tok = s < 8 ? s * SEQ + SEQ - 1 : NPR + (s - 8) * ST + ST - 1;
        float f[8]; unpack8(*(const u32x4*)(PJ + (size_t)tok * NPJ + c8), f); float* o = F.out + (s < 8 ? O_PSH : O_SSH) + ((size_t)l * 8 + (s & 7)) * RC + c8;
        *(f32x4*)o = (f32x4){f[0], f[1], f[2], f[3]}; *(f32x4*)(o + 4) = (f32x4){f[4], f[5], f[6], f[7]}; }
    for (size_t i = gt; i < (size_t)8 * 512 * 128; i += gs) { const int c8 = (int)(i & 127) * 8, r = (int)((i >> 7) & 511), b = (int)(i >> 16); const int tok = b * SEQ + SEQ - 512 + r;
        float f[8]; unpack8(*(const u32x4*)(PJ + (size_t)tok * NPJ + AT_OFF + 512 + c8), f);
        float* o = F.out + (c8 < 512 ? O_PK : O_PV) + (((size_t)l * NB + b) * 512 + r) * 512 + (c8 & 511);
        *(f32x4*)o = (f32x4){f[0], f[1], f[2], f[3]}; *(f32x4*)(o + 4) = (f32x4){f[4], f[5], f[6], f[7]}; }
    for (size_t i = gt; i < (size_t)NSA * 128; i += gs) { const int c8 = (int)(i & 127) * 8, r = (int)(i >> 7); const int tok = NPR + r;
        float f[8]; unpack8(*(const u32x4*)(PJ + (size_t)tok * NPJ + AT_OFF + 512 + c8), f);
        float* o = F.out + (c8 < 512 ? O_SK : O_SV) + ((size_t)l * NSA + r) * 512 + (c8 & 511);
        *(f32x4*)o = (f32x4){f[0], f[1], f[2], f[3]}; *(f32x4*)(o + 4) = (f32x4){f[4], f[5], f[6], f[7]}; }
}

__device__ __forceinline__ void ph_mixers(const Frame& F, int l) {
    REP(12) attn_jobs(F, l);
    REP(14) for (int u = F.c; u < 256 + 8; u += F.G) conv_unit(F, l, u);
    REP(15) { const int si = F.gw - 100 * NWAVE;
              for (int k = 0; k < 2; ++k) { int tt = -1, lo = 0, n = 0;
                  if (k == 0) { if (F.gw < (NPR / 16) * 2) { tt = F.gw >> 1; lo = 4 * (F.gw & 1); n = 4; } } else if (si >= 0 && si < 64) { tt = NPR / 16 + (si >> 3); lo = si & 7; n = 1; }
                  if (tt >= 0) rwkv_prep_unit(F, l, tt, lo, n); }
              for (int k = 0; k < 2; ++k) { int tt = -1, lo = 0, n = 0;
                  if (k == 0) { if (F.gw < (NPR / 16) * 2) { tt = F.gw >> 1; lo = 16 * (F.gw & 1); n = 16; } } else if (si >= 64 && si < 128) { tt = NPR / 16 + ((si - 64) >> 3); lo = 4 * (si & 7); n = 4; }
                  if (tt >= 0) rwkv_gate_unit(F, l, tt, lo, n); } }
    REP(16) state_copies(F, l);
}

constexpr int SG = 5;
__device__ __forceinline__ void scan_block(const Frame& F, int tokbase, int nchunk, int h, const float* S0, float* Sout, float* Y) {
    const int lane = F.lane, w = F.wave, fr = lane & 15, fq = lane >> 4, rt = w & 3, row = 16 * rt + fr;
    const bool cons = w < 4;
#define SCAN_BAR() do { asm volatile("" ::: "memory"); __builtin_amdgcn_s_barrier(); asm volatile("" ::: "memory"); } while (0)
    f32x4 ST[4];
#pragma unroll
    for (int kt = 0; kt < 4; ++kt) ST[kt] = (cons && S0) ? *(const f32x4*)(S0 + row * 64 + 16 * kt + 4 * fq) : (f32x4){0.f, 0.f, 0.f, 0.f};
    const unsigned char* rec0 = F.ws + WS_REC + ((size_t)(tokbase / 16) * 8 + h) * REC_BYTES;
    const int ngroup = (nchunk + SG - 1) / SG;
#define SCAN_FILL(g_) do { const int g0_ = (g_) * SG, nck_ = nchunk - g0_ < SG ? nchunk - g0_ : SG; \
        for (int p_ = w - 4; p_ < nck_ * 14; p_ += 4) { const int ci_ = p_ / 14, pi_ = p_ - 14 * ci_; \
            __builtin_amdgcn_global_load_lds((const unsigned*)(rec0 + (size_t)(g0_ + ci_) * 8 * REC_BYTES + pi_ * 1024 + lane * 16), (LAS unsigned*)(F.lds + ((g_) & 1) * (SG * REC_BYTES) + ci_ * REC_BYTES + pi_ * 1024), 16, 0, 0); } } while (0)
    if (!cons) { SCAN_FILL(0); asm volatile("s_waitcnt vmcnt(0)" ::: "memory"); }
    SCAN_BAR();
    for (int g = 0; g < ngroup; ++g) {
        if (!cons) { if (g + 1 < ngroup) SCAN_FILL(g + 1); asm volatile("s_waitcnt vmcnt(0)" ::: "memory"); }
        else {
            const int g0 = g * SG, nck = nchunk - g0 < SG ? nchunk - g0 : SG;
            for (int ci = 0; ci < nck; ++ci) {
                LAS unsigned char* base = F.lds + (g & 1) * (SG * REC_BYTES) + ci * REC_BYTES;
                bf16x8 f[11];
#pragma unroll
                for (int i = 0; i < 11; ++i) f[i] = *(const LAS bf16x8*)(base + i * 1024 + lane * 16);
                const u32x2 fv = *(const LAS u32x2*)(base + REC_FV + rt * 512 + lane * 8);
                f32x4 gg[4];
#pragma unroll
                for (int kt = 0; kt < 4; ++kt) gg[kt] = *(const LAS f32x4*)(base + REC_G16 + (16 * kt + 4 * fq) * 4);
                bf16x8 sb[2];
#pragma unroll
                for (int ks = 0; ks < 2; ++ks) { const float x[8] = {ST[2 * ks][0], ST[2 * ks][1], ST[2 * ks][2], ST[2 * ks][3], ST[2 * ks + 1][0], ST[2 * ks + 1][1], ST[2 * ks + 1][2], ST[2 * ks + 1][3]}; sb[ks] = pack_frag(x); }
                const bf16x8 vB = __builtin_bit_cast(bf16x8, (u32x4){fv.x, fv.y, 0u, 0u});
                f32x4 aP = (f32x4){0.f, 0.f, 0.f, 0.f};
                aP = __builtin_amdgcn_mfma_f32_16x16x32_bf16(f[0], sb[0], aP, 0, 0, 0); aP = __builtin_amdgcn_mfma_f32_16x16x32_bf16(f[1], sb[1], aP, 0, 0, 0); aP = __builtin_amdgcn_mfma_f32_16x16x32_bf16(f[4], vB, aP, 0, 0, 0);
                const bf16x8 pB = __builtin_bit_cast(bf16x8, (u32x4){pk2(aP[0], aP[1]), pk2(aP[2], aP[3]), 0u, 0u});
                f32x4 aU = (f32x4){0.f, 0.f, 0.f, 0.f};
                aU = __builtin_amdgcn_mfma_f32_16x16x32_bf16(f[5], pB, aU, 0, 0, 0);
                const bf16x8 uvB = __builtin_bit_cast(bf16x8, (u32x4){pk2(aU[0], aU[1]), pk2(aU[2], aU[3]), fv.x, fv.y});
                f32x4 aY = (f32x4){0.f, 0.f, 0.f, 0.f};
                aY = __builtin_amdgcn_mfma_f32_16x16x32_bf16(f[2], sb[0], aY, 0, 0, 0); aY = __builtin_amdgcn_mfma_f32_16x16x32_bf16(f[3], sb[1], aY, 0, 0, 0); aY = __builtin_amdgcn_mfma_f32_16x16x32_bf16(f[6], uvB, aY, 0, 0, 0);
                float* yp = Y + (size_t)(tokbase + 16 * (g0 + ci) + 4 * fq) * 512 + h * 64 + row;
#pragma unroll
                for (int j = 0; j < 4; ++j) yp[(size_t)j * 512] = aY[j];
#pragma unroll
                for (int kt = 0; kt < 4; ++kt) { ST[kt] = __builtin_amdgcn_mfma_f32_16x16x32_bf16(f[7 + kt], uvB, ST[kt], 0, 0, 0); ST[kt] *= gg[kt]; }
            }
        }
        SCAN_BAR();
    }
    if (cons) {
#pragma unroll
        for (int kt = 0; kt < 4; ++kt) *(f32x4*)(Sout + row * 64 + 16 * kt + 4 * fq) = ST[kt]; }
#undef SCAN_FILL
#undef SCAN_BAR
}
__device__ __forceinline__ void ph_scan(const Frame& F, int l) {
    float* Y = WSP(float, WS_Y);
    for (int item = F.c; item < 128; item += F.G) {
        const bool pr = item < 64; const int bh = item & 63, b = bh >> 3, h = bh & 7;
        const size_t so = (((size_t)l * 8 + b) * 8 + h) * 4096;
        scan_block(F, pr ? b * SEQ : NPR + b * ST, pr ? SEQ / 16 : 1, h, pr ? nullptr : F.in[3] + so, F.out + (pr ? O_PWKV : O_SWKV) + so, Y);
    }
}

__device__ __forceinline__ void ph_finish(const Frame& F, int l) {
    const float* Y = WSP(float, WS_Y); const bf16_t* V = (const bf16_t*)(WSP(float, WS_SCAN) + 3 * (size_t)MR * 512); const bf16_t* GG = WSP(bf16_t, WS_G);     const float* BON = WSP(float, WS_BON);
    const float* gnw = F.in[20] + l * 512; const float* gnb = F.in[21] + l * 512;
    const int l16 = F.lane & 15, sub = F.lane >> 4;
    for (int it = F.gw; it < MR * 8 / 4; it += F.G * NWAVE) {
        const int idx = it * 4 + sub, tok = idx >> 3, hd = idx & 7, col = hd * 64 + 4 * l16;
        const f32x4 y = *(const f32x4*)(Y + (size_t)tok * 512 + col);
        const float mean = row16_sum(y[0] + y[1] + y[2] + y[3]) * (1.0f / 64.0f);
        const f32x4 d = y - mean;
        const float var = row16_sum(d[0] * d[0] + d[1] * d[1] + d[2] * d[2] + d[3] * d[3]) * (1.0f / 64.0f);
        const float rstd = __builtin_amdgcn_rsqf(var + 64e-5f);
        const f32x4 gw4 = *(const f32x4*)(gnw + col), gb4 = *(const f32x4*)(gnb + col), v4 = ({ const u32x2 t_ = *(const u32x2*)(V + (size_t)tok * 512 + col); (f32x4){bflo(t_.x), bfhi(t_.x), bflo(t_.y), bfhi(t_.y)}; }), g4 = ({ const u32x2 t_ = *(const u32x2*)(GG + (size_t)tok * 512 + col); (f32x4){bflo(t_.x), bfhi(t_.x), bflo(t_.y), bfhi(t_.y)}; });
        const float bon = BON[(size_t)tok * 8 + hd];
        const f32x4 o = (d * rstd * gw4 + gb4 + bon * v4) * g4;
        u32x2 w; w.x = pk2(o[0], o[1]); w.y = pk2(o[2], o[3]);
        *(u32x2*)(WSP(bf16_t, WS_OCAT) + (size_t)tok * DM + col) = w;
    }
}

template <bool DUAL, int STEPS>
__device__ __forceinline__ void skinny_trip(const bf16_t* __restrict__ wrow, const bf16_t* __restrict__ arow, const int K, const int ks, f32x4 (&acc)[4], f32x4 (&acc2)[4]) {
    bf16x8 wf[STEPS], wf2[STEPS], af[STEPS][4];
#pragma unroll
    for (int u = 0; u < STEPS; ++u) { wf[u] = *(const bf16x8*)(wrow + 32 * (ks + u)); if (DUAL) wf2[u] = *(const bf16x8*)(wrow + (size_t)128 * K + 32 * (ks + u));
#pragma unroll
        for (int rt = 0; rt < 4; ++rt) af[u][rt] = *(const bf16x8*)(arow + (size_t)rt * 16 * K + 32 * (ks + u)); }
    __builtin_amdgcn_sched_barrier(0);
#pragma unroll
    for (int u = 0; u < STEPS; ++u)
#pragma unroll
        for (int rt = 0; rt < 4; ++rt) { acc[rt] = __builtin_amdgcn_mfma_f32_16x16x32_bf16(wf[u], af[u][rt], acc[rt], 0, 0, 0);
            if (DUAL) acc2[rt] = __builtin_amdgcn_mfma_f32_16x16x32_bf16(wf2[u], af[u][rt], acc2[rt], 0, 0, 0); }
    __builtin_amdgcn_sched_barrier(0);
}
__device__ __forceinline__ void skinny_gemm(const Frame& F, const int MODE, const bf16_t* __restrict__ A, const bf16_t* __restrict__ Wt, const int K, const int nslices) {
    const int lane = F.lane, w = F.wave, c16 = lane & 15, qd = lane >> 4;
    LAS f32x4* red = (LAS f32x4*)F.lds;
    const int kw = K / 8, nks = kw / 32;
    for (int item = F.c; item < 2 * nslices; item += F.G) {
        const int sl = item >> 1, rh = item & 1, n0 = sl * 16;
        const bf16_t* wrow = Wt + (size_t)(MODE == 2 ? 256 * (n0 >> 7) + (n0 & 127) + c16 : n0 + c16) * K + w * kw + 8 * qd;
        const bf16_t* arow = A + (size_t)(NPR + rh * 64 + c16) * K + w * kw + 8 * qd;
        f32x4 acc[4], acc2[4];
#pragma unroll
        for (int rt = 0; rt < 4; ++rt) { acc[rt] = (f32x4){0.f, 0.f, 0.f, 0.f}; acc2[rt] = acc[rt]; }
        int ks = 0;
        if (MODE == 2) { for (; ks + 4 <= nks; ks += 4) skinny_trip<true, 4>(wrow, arow, K, ks, acc, acc2); }
        else { for (; ks + 4 <= nks; ks += 4) skinny_trip<false, 4>(wrow, arow, K, ks, acc, acc2); if (ks < nks) skinny_trip<false, 2>(wrow, arow, K, ks, acc, acc2); }
#pragma unroll
        for (int rt = 0; rt < 4; ++rt) { red[(w * 4 + rt) * 64 + lane] = acc[rt]; if (MODE == 2) red[2048 + (w * 4 + rt) * 64 + lane] = acc2[rt]; }
        __syncthreads();
        if (w < 4) { const int rt = w, tok = NPR + rh * 64 + rt * 16 + c16, n = n0 + 4 * qd;
          if (MODE == 0) { f32x4 sum = (f32x4){0.f, 0.f, 0.f, 0.f};
#pragma unroll
              for (int ww = 0; ww < 8; ++ww) sum += red[(ww * 4 + rt) * 64 + lane];
              bf16_t* xp = WSP(bf16_t, WS_X) + (size_t)tok * DM + n; const u32x2 xo = *(const u32x2*)xp;
              u32x2 o; o.x = pk2(bflo(xo.x) + sum[0], bfhi(xo.x) + sum[1]); o.y = pk2(bflo(xo.y) + sum[2], bfhi(xo.y) + sum[3]); *(u32x2*)xp = o; }
          if (MODE == 1) { f32x4 tot = (f32x4){0.f, 0.f, 0.f, 0.f}; const bf16_t* gp0 = WSP(bf16_t, WS_PROJ) + (size_t)tok * NPJ + GT_OFF;
#pragma unroll
              for (int b = 0; b < 4; ++b) { const f32x4 sb = red[((2 * b) * 4 + rt) * 64 + lane] + red[((2 * b + 1) * 4 + rt) * 64 + lane]; const unsigned gw = *(const unsigned*)((const unsigned char*)gp0 + b * DM + n);
                  tot += sb * ((f32x4){(float)((gw >> 0) & 0xffu), (float)((gw >> 8) & 0xffu), (float)((gw >> 16) & 0xffu), (float)((gw >> 24) & 0xffu)} * (1.0f / 255.0f)); }
              u32x2 o; o.x = pk2(tot[0], tot[1]); o.y = pk2(tot[2], tot[3]); *(u32x2*)(WSP(bf16_t, WS_MRG) + (size_t)tok * DM + n) = o; }
          if (MODE == 2) { f32x4 sg = (f32x4){0.f, 0.f, 0.f, 0.f}, su = sg;
#pragma unroll
              for (int ww = 0; ww < 8; ++ww) { sg += red[(ww * 4 + rt) * 64 + lane]; su += red[2048 + (ww * 4 + rt) * 64 + lane]; }
              u32x2 o; o.x = pk2(sg[0] * sigm(sg[0]) * su[0], sg[1] * sigm(sg[1]) * su[1]); o.y = pk2(sg[2] * sigm(sg[2]) * su[2], sg[3] * sigm(sg[3]) * su[3]);
              *(u32x2*)(WSP(bf16_t, WS_PROJ) + (size_t)tok * DFF + n) = o; } }
        __syncthreads();
    }
}

__global__ void __launch_bounds__(NTHR, 2) mega(Params P) {
    extern __shared__ __attribute__((aligned(16))) unsigned char lds_raw[];
    Frame F;
    F.lds = (LAS unsigned char*)lds_raw; F.tid = threadIdx.x; F.lane = F.tid & 63; F.wave = __builtin_amdgcn_readfirstlane(F.tid >> 6);
    F.G = gridDim.x; F.c = blockIdx.x; F.gw = F.c * NWAVE + F.wave; F.in = P.in; F.out = P.out; F.ws = P.ws;
    const int lo = P.lo, hi = P.hi;
    const int wave0_ = __builtin_amdgcn_readfirstlane(threadIdx.x >> 6);
#define REFRAME() do { int t_ = wave0_ * 64 + (int)__builtin_amdgcn_mbcnt_hi(~0u, __builtin_amdgcn_mbcnt_lo(~0u, 0u)), c_ = blockIdx.x; asm volatile("" : "+v"(t_)); asm volatile("" : "+s"(c_)); F.tid = t_; F.lane = t_ & 63; F.wave = __builtin_amdgcn_readfirstlane(t_ >> 6); \
        F.c = c_; F.gw = c_ * NWAVE + F.wave; } while (0)
    XcdBarrier bar; bar.bar = (unsigned*)(P.ws + WS_CTL); bar.x = 0; bar.st = (volatile LAS unsigned*)(F.lds + LDS_BAR_OFF);
    if (hi - lo > 1) {
        if (F.tid == 0) { bar.st[0] = 0u; bar.st[1] = 0u; bar.st[2] = 0u; bar.st[3] = 0u; }
        __syncthreads();
        bar = xcd_barrier_post((unsigned*)(P.ws + WS_CTL), (volatile LAS unsigned*)(F.lds + LDS_BAR_OFF));
    }
    int ph = 0;
#define PHASE_BEGIN if (ph >= lo && ph < hi) { REFRAME();
#define PHASE_END   if (ph + 1 < hi) xcd_barrier(bar); } ++ph;
    PHASE_BEGIN REP(0) { ph_prep(F); __syncthreads(); ph_rmsnorm<false>(F, F.in[7], true); } PHASE_END
    for (int gi = 0; gi < NL * 5; ++gi) {
        const int l = gi / 5, k = gi - 5 * l;
        if ((k == 0 && gi != 0) || k == 3) { PHASE_BEGIN REP(1) ph_rmsnorm<false>(F, F.in[k == 0 ? 7 : 8] + l * DM, false); PHASE_END }
        if (k == 1) {
            PHASE_BEGIN ph_mixers(F, l); PHASE_END
            PHASE_BEGIN REP(4) { ph_scan(F, l); __syncthreads(); }
                        for (int u = (F.c + F.G - 64) % F.G; u < 128 + 8; u += F.G) gmlp_unit(F, l, u);
            PHASE_END
            PHASE_BEGIN REP(5) ph_finish(F, l); PHASE_END
        }
        PHASE_BEGIN REP(2) {
            const bf16_t* A = WSP(bf16_t, k == 0 || k == 3 ? WS_H : k == 1 ? WS_OCAT : k == 2 ? WS_MRG : WS_PROJ);
            const bf16_t* Bt = k == 0 ? WSP(bf16_t, WS_WIN) + (size_t)l * NPJ * DM : k == 1 ? WSP(bf16_t, WS_WBR) + (size_t)l * DM * DM : k == 2 ? WSP(bf16_t, WS_WOUT) + (size_t)l * DM * DM
                             : k == 3 ? WSP(bf16_t, WS_WFI) + (size_t)l * 2 * DFF * DM : WSP(bf16_t, WS_WFO) + (size_t)l * DM * DFF;
            const int M = k == 0 ? MP : NPR, N = k == 0 ? NPJ : k == 3 ? 2 * DFF : DM, K = k == 4 ? DFF : DM;
            pg8::Gemm g{A, Bt, M, N, K}; pg8::StaticOrder S; S.init(M, N, F.G, F.c);
            pg8::EpiAny E{k == 0 ? 0 : k == 1 ? 1 : k == 3 ? 3 : 2, k == 1 ? WSP(bf16_t, WS_MRG) : WSP(bf16_t, WS_PROJ), WSP(bf16_t, WS_PROJ) + GT_OFF, WSP(bf16_t, WS_X)};
            pg8::gemm_phase<pg8::EpiAny, pg8::StaticOrder>(F.lds, g, S, E, F.tid);
            if (k != 0) skinny_gemm(F, k == 1 ? 1 : k == 3 ? 2 : 0, A, Bt, K, k == 3 ? DFF / 16 : DM / 16);
        } PHASE_END
    }
    PHASE_BEGIN ph_rmsnorm<true>(F, F.in[9], false); PHASE_END
}
constexpr int NPHASE = 1 + NL * 10 + 1 - 1;

extern "C" void kernel_launch(void* const* d_in, const int* in_sizes, int n_in, void* d_out, int out_size, void* d_ws, size_t ws_size, hipStream_t stream) {
    static int grid = 0;
    if (grid == 0) {
        if (n_in != 35 || (size_t)out_size != O_END || ws_size < WS_END) { fprintf(stderr, "kernel_launch: unexpected shapes: n_in %d out %d (want %zu) ws %zu (want %zu)\n", n_in, out_size, (size_t)O_END, ws_size, (size_t)WS_END); grid = -1; return; }
        int dev = 0, cus = 0, per_cu = 0;
        if (hipGetDevice(&dev) != hipSuccess || hipDeviceGetAttribute(&cus, hipDeviceAttributeMultiprocessorCount, dev) != hipSuccess) { fprintf(stderr, "kernel_launch: device query failed\n"); grid = -1; return; }
        if (hipFuncSetAttribute((const void*)mega, hipFuncAttributeMaxDynamicSharedMemorySize, LDS_BYTES) != hipSuccess) { fprintf(stderr, "kernel_launch: hipFuncSetAttribute failed\n"); grid = -1; return; }
        if (hipOccupancyMaxActiveBlocksPerMultiprocessor(&per_cu, (const void*)mega, NTHR, LDS_BYTES) != hipSuccess || per_cu < 1) fprintf(stderr, "kernel_launch: occupancy query says %d\n", per_cu);
        (void)hipGetLastError();
        grid = cus;
    }
    if (grid < 0) return;
    (void)hipMemsetAsync((char*)d_ws + WS_CTL, 0, CTL_BYTES, stream);
    Params p{};
    for (int i = 0; i < 35; ++i) p.in[i] = (const float*)d_in[i];
    p.out = (float*)d_out; p.ws = (unsigned char*)d_ws;
#if ONE_LAUNCH
    p.lo = 0; p.hi = NPHASE;
    hipLaunchKernelGGL(mega, dim3(grid), dim3(NTHR), LDS_BYTES, stream, p);
#else
    for (int i = 0; i < NPHASE; ++i) { p.lo = i; p.hi = i + 1; hipLaunchKernelGGL(mega, dim3(grid), dim3(NTHR), LDS_BYTES, stream, p); }
#endif
    const hipError_t le = hipPeekAtLastError();
    if (le != hipSuccess) fprintf(stderr, "kernel_launch: launch failed: %s\n", hipGetErrorName(le));
}
```

```cpp
#include <hip/hip_runtime.h>
#include <cstdio>
#include <cstdint>

#define LAS __attribute__((address_space(3)))
typedef unsigned short bf16_t;
typedef short bf16x8 __attribute__((ext_vector_type(8)));
typedef short s16x4 __attribute__((ext_vector_type(4)));
typedef float f32x4 __attribute__((ext_vector_type(4)));
typedef float f32x2 __attribute__((ext_vector_type(2)));
typedef unsigned u32x4 __attribute__((ext_vector_type(4)));
typedef unsigned u32x2 __attribute__((ext_vector_type(2)));

#ifndef ONE_LAUNCH
#define ONE_LAUNCH 1
#endif
#ifndef PHMASK
#define PHMASK 0xFFFFFFFFu
#endif
#define EN(k) (((PHMASK) >> (k)) & 1u)
#ifndef DUPMASK
#define DUPMASK 0u
#endif
#define REP(k) for (int rep_ = 0; rep_ < 1 + (int)(((DUPMASK) >> (k)) & 1u); ++rep_)

constexpr int DM = 2048, NB = 8, SEQ = 2048, NL = 4, SB = 8, ST = 16;
constexpr int NPR = NB * SEQ, NSA = SB * ST, MR = NPR + NSA, MP = 16640;
constexpr int RC = 1984, INC = 13760, NPJ = 13824, DFF = 5632;
constexpr int GM_OFF = 2048, CV_OFF = 3072, AT_OFF = 4096, GT_OFF = 5632;
constexpr int NTHR = 512, NWAVE = 8;
constexpr int LDS_BYTES = 155648;
constexpr int LDS_BAR_OFF = 155648 - 64;

constexpr size_t O_YP = 0, O_YS = O_YP + (size_t)NPR * DM, O_PSH = O_YS + (size_t)NSA * DM, O_PWKV = O_PSH + (size_t)NL * NB * RC,
                 O_PCV = O_PWKV + (size_t)NL * NB * 8 * 64 * 64, O_PK = O_PCV + (size_t)NL * NB * 30 * 512, O_PV = O_PK + (size_t)NL * NB * 512 * 512,
                 O_SSH = O_PV + (size_t)NL * NB * 512 * 512, O_SWKV = O_SSH + (size_t)NL * SB * RC, O_SCV = O_SWKV + (size_t)NL * SB * 8 * 64 * 64,
                 O_SK = O_SCV + (size_t)NL * SB * 30 * 512, O_SV = O_SK + (size_t)NL * SB * ST * 512, O_SGV = O_SV + (size_t)NL * SB * ST * 512,
                 O_END = O_SGV + (size_t)NL * SB * ST * 512;

constexpr size_t WS_CTL = 0, CTL_BYTES = 1u << 20;
constexpr size_t WS_WIN = WS_CTL + CTL_BYTES;
constexpr size_t WS_WBR = WS_WIN + (size_t)NL * NPJ * DM * 2;
constexpr size_t WS_WOUT = WS_WBR + (size_t)NL * DM * DM * 2;
constexpr size_t WS_WFI = WS_WOUT + (size_t)NL * DM * DM * 2;
constexpr size_t WS_WFO = WS_WFI + (size_t)NL * 2 * DFF * DM * 2;
constexpr size_t WS_W2T = WS_WFO + (size_t)NL * DM * DFF * 2;
constexpr size_t WS_A2T = WS_W2T + (size_t)NL * 512 * 96 * 2;
constexpr size_t WS_G2T = WS_A2T + (size_t)NL * 512 * 96 * 2;
constexpr size_t WS_WSB = WS_G2T + (size_t)NL * 512 * 256 * 2;
constexpr size_t WS_CK = WS_WSB + (size_t)NL * 8 * 128 * 128 * 2;
constexpr size_t WS_CVV = WS_CK + (size_t)NL * SB * 512 * 512 * 2;
constexpr size_t WS_X = WS_CVV + (size_t)NL * SB * 512 * 512 * 2;
constexpr size_t WS_H = WS_X + (size_t)MP * DM * 4;
constexpr size_t WS_PROJ = WS_H + (size_t)MP * DM * 2;
constexpr size_t WS_OCAT = WS_PROJ + (size_t)MP * NPJ * 2;
constexpr size_t WS_MRG = WS_OCAT + (size_t)MP * DM * 2;
constexpr size_t WS_SCAN = WS_MRG + (size_t)MP * DM * 2;
constexpr size_t SCAN_ARR = (size_t)MR * 512 * 4;
constexpr size_t WS_G = WS_SCAN + 6 * SCAN_ARR;
constexpr size_t WS_Y = WS_G + SCAN_ARR;
constexpr size_t WS_BON = WS_Y + SCAN_ARR;
constexpr size_t WS_SHS = WS_BON + (size_t)MR * 8 * 4;
constexpr size_t WS_ZROW = WS_SHS + (size_t)NL * SB * 2048 * 2;
constexpr int REC_BYTES = 14336, REC_FV = 11264, REC_G16 = 13312;
constexpr size_t WS_REC = WS_ZROW + 4096;
constexpr size_t WS_END = WS_REC + (size_t)(MR / 16) * 8 * REC_BYTES;

struct Params { const float* in[35]; float* out; unsigned char* ws; int lo, hi; };

typedef __bf16 bf16x2_t __attribute__((ext_vector_type(2)));
__device__ __forceinline__ unsigned pk2(float lo, float hi) { const f32x2 v = {lo, hi}; const bf16x2_t b = __builtin_convertvector(v, bf16x2_t); return __builtin_bit_cast(unsigned, b); }
__device__ __forceinline__ float bflo(unsigned u) { return __uint_as_float(u << 16); }
__device__ __forceinline__ float bfhi(unsigned u) { return __uint_as_float(u & 0xffff0000u); }
__device__ __forceinline__ float bf1(bf16_t b) { return __uint_as_float(((unsigned)b) << 16); }
__device__ __forceinline__ float fexp(float x) { return __builtin_amdgcn_exp2f(x * 1.44269504089f); }
__device__ __forceinline__ float frcp(float x) { return __builtin_amdgcn_rcpf(x); }
__device__ __forceinline__ float sigm(float x) { return frcp(1.0f + fexp(-x)); }
__device__ __forceinline__ float ftanh(float x) { return 1.0f - 2.0f * frcp(1.0f + fexp(2.0f * x)); }
__device__ __forceinline__ float gelu_t(float x) { const float u = 1.5957691216f * (x + 0.044715f * x * x * x); return x * sigm(u); }
__device__ __forceinline__ float wave_sum(float v) {
#pragma unroll
    for (int o = 32; o >= 1; o >>= 1) v += __shfl_xor(v, o);
    return v;
}
__device__ __forceinline__ float row16_sum(float v) {
    v += __int_as_float(__builtin_amdgcn_update_dpp(0, __float_as_int(v), 0xB1, 0xF, 0xF, true));
    v += __int_as_float(__builtin_amdgcn_update_dpp(0, __float_as_int(v), 0x4E, 0xF, 0xF, true));
    v += __int_as_float(__builtin_amdgcn_update_dpp(0, __float_as_int(v), 0x141, 0xF, 0xF, true));
    v += __int_as_float(__builtin_amdgcn_update_dpp(0, __float_as_int(v), 0x140, 0xF, 0xF, true));
    return v;
}
typedef short v4i16_t __attribute__((ext_vector_type(4)));
__device__ __forceinline__ s16x4 lds_tr(LAS unsigned char* p) { return __builtin_bit_cast(s16x4, __builtin_amdgcn_ds_read_tr16_b64_v4i16((LAS v4i16_t*)p)); }
__device__ __forceinline__ bf16x8 cat8(s16x4 a, s16x4 b) { return __builtin_shufflevector(a, b, 0, 1, 2, 3, 4, 5, 6, 7); }
__device__ __forceinline__ void ub8(const u32x2 w, float (&f)[8]) {
    f[0] = (float)((w.x >> 0) & 0xffu); f[1] = (float)((w.x >> 8) & 0xffu); f[2] = (float)((w.x >> 16) & 0xffu); f[3] = (float)((w.x >> 24) & 0xffu);
    f[4] = (float)((w.y >> 0) & 0xffu); f[5] = (float)((w.y >> 8) & 0xffu); f[6] = (float)((w.y >> 16) & 0xffu); f[7] = (float)((w.y >> 24) & 0xffu);
}
__device__ __forceinline__ unsigned gq(float g) { return (unsigned)fminf(fmaxf(g * 255.0f + 0.5f, 1.0f), 255.0f); }
__device__ __forceinline__ void unpack8(const u32x4 w, float (&f)[8]) {
    f[0] = bflo(w.x); f[1] = bfhi(w.x); f[2] = bflo(w.y); f[3] = bfhi(w.y); f[4] = bflo(w.z); f[5] = bfhi(w.z); f[6] = bflo(w.w); f[7] = bfhi(w.w);
}

namespace pg8 {
#define PG8_LAS __attribute__((address_space(3)))
constexpr int BM = 256, BK = 64, HALF = 128, HTB = HALF * BK * 2, STAGE_BYTES = 8 * HTB, NXCD = 8, WGM = 8;
__host__ __device__ __forceinline__ int lds_byte(int r, int c) { const int st = (r >> 4) * 2 + (c >> 5), rr = r & 15, cc = c & 31, ob = rr * 64 + cc * 2; return st * 1024 + (ob ^ (((ob >> 9) & 1) << 5)); }
__host__ __device__ __forceinline__ void stage_rc(int b, int& R, int& C) { const int st = b / 1024, sb = b % 1024, swz = sb ^ (((sb >> 9) & 1) << 5); R = (st >> 1) * 16 + swz / 64; C = (st & 1) * 32 + (swz % 64) / 2; }
__host__ __device__ __forceinline__ int perm32(int rho) { const int n = rho >> 4, i = rho & 15; return 8 * (i >> 2) + 4 * n + (i & 3); }
struct Unit { int pm, pn; };
struct Gemm { const bf16_t* A; const bf16_t* Bt; int M, N, K; };
struct StaticOrder {
    int nM, nN, nwg, G, c;
    __host__ __device__ void init(int M, int N, int G_, int c_) { nM = M / BM; nN = N / BM; nwg = nM * nN; G = G_; c = c_; }
    __host__ __device__ bool next(int i, Unit& u) const {
        const long L = (long)i * G + c; if (L >= nwg) return false;
        int wgid = (int)L; { const int q = nwg / NXCD, r = nwg % NXCD, xcd = wgid % NXCD, off = wgid / NXCD; wgid = (xcd < r ? xcd * (q + 1) : r * (q + 1) + (xcd - r) * q) + off; }
        const int nig = WGM * nN, gid = wgid / nig, fm = gid * WGM, gsz = (nM - fm) < WGM ? (nM - fm) : WGM;
        u.pm = fm + ((wgid % nig) % gsz); u.pn = (wgid % nig) / gsz; return true;
    }
    __device__ __forceinline__ void a_ready(const Unit&) const {}
    __device__ __forceinline__ void done(const Unit&) const {}
};

struct EpiProj {
    static constexpr bool PERM = true, AFTER_DRAIN = false, MID = false;
    bf16_t* O;
    __device__ __forceinline__ void mid(f32x4 (&)[2][2][4][2], const Unit&, int, int, int, int, int) const {}
    __device__ __forceinline__ void operator()(f32x4 (&acc)[2][2][4][2], const Unit& u, int wr, int wc, int fr, int fq) const {
        const int row0 = u.pm * BM + wr * 64 + fr, col0 = u.pn * BM + wc * 64 + 8 * fq; const bool gate = u.pn >= (GT_OFF / 256);
#pragma unroll
        for (int ai = 0; ai < 2; ++ai)
#pragma unroll
            for (int m = 0; m < 4; ++m) { bf16_t* rowp = O + (size_t)(row0 + ai * HALF + m * 16) * NPJ + col0;
#pragma unroll
                for (int bj = 0; bj < 2; ++bj) { const f32x4 v0 = acc[ai][bj][m][0], v1 = acc[ai][bj][m][1];
                    if (gate) {
                        u32x2 q; q.x = gq(sigm(v0[0])) | (gq(sigm(v0[1])) << 8) | (gq(sigm(v0[2])) << 16) | (gq(sigm(v0[3])) << 24); q.y = gq(sigm(v1[0])) | (gq(sigm(v1[1])) << 8) | (gq(sigm(v1[2])) << 16) | (gq(sigm(v1[3])) << 24);
                        *(u32x2*)((unsigned char*)(rowp - col0 + GT_OFF) + (col0 - GT_OFF) + bj * 32) = q;
                    } else {
                        u32x4 w; w.x = pk2(v0[0], v0[1]); w.y = pk2(v0[2], v0[3]); w.z = pk2(v1[0], v1[1]); w.w = pk2(v1[2], v1[3]);
                        *(u32x4*)(rowp + bj * 32) = w; } } }
    }
};
struct EpiSwiGLU {
    static constexpr bool PERM = true, AFTER_DRAIN = false, MID = false;
    bf16_t* O;
    __device__ __forceinline__ void mid(f32x4 (&)[2][2][4][2], const Unit&, int, int, int, int, int) const {}
    __device__ __forceinline__ void operator()(f32x4 (&acc)[2][2][4][2], const Unit& u, int wr, int wc, int fr, int fq) const {
        const int row0 = u.pm * BM + wr * 64 + fr, col0 = u.pn * HALF + wc * 32 + 8 * fq;
#pragma unroll
        for (int ai = 0; ai < 2; ++ai)
#pragma unroll
            for (int m = 0; m < 4; ++m) { bf16_t* rowp = O + (size_t)(row0 + ai * HALF + m * 16) * DFF + col0;
                f32x4 v0, v1;
#pragma unroll
                for (int j = 0; j < 4; ++j) { const float g0 = acc[ai][0][m][0][j], g1 = acc[ai][0][m][1][j]; v0[j] = g0 * sigm(g0) * acc[ai][1][m][0][j]; v1[j] = g1 * sigm(g1) * acc[ai][1][m][1][j]; }
                u32x4 w; w.x = pk2(v0[0], v0[1]); w.y = pk2(v0[2], v0[3]); w.z = pk2(v1[0], v1[1]); w.w = pk2(v1[2], v1[3]);
                *(u32x4*)rowp = w; }
    }
};
struct EpiResid {
    static constexpr bool PERM = true, AFTER_DRAIN = false, MID = false;
    bf16_t* X;
    __device__ __forceinline__ void mid(f32x4 (&)[2][2][4][2], const Unit&, int, int, int, int, int) const {}
    __device__ __forceinline__ void operator()(f32x4 (&acc)[2][2][4][2], const Unit& u, int wr, int wc, int fr, int fq) const {
        const int row0 = u.pm * BM + wr * 64 + fr, col0 = u.pn * BM + wc * 32 + 8 * fq;
#pragma unroll
        for (int ai = 0; ai < 2; ++ai) { u32x4 xb[4][2];
#pragma unroll
            for (int m = 0; m < 4; ++m) { const bf16_t* rowp = X + (size_t)(row0 + ai * HALF + m * 16) * DM + col0;
#pragma unroll
                for (int bj = 0; bj < 2; ++bj) xb[m][bj] = *(const u32x4*)(rowp + bj * HALF); }
            __builtin_amdgcn_sched_barrier(0);
#pragma unroll
            for (int m = 0; m < 4; ++m) { bf16_t* rowp = X + (size_t)(row0 + ai * HALF + m * 16) * DM + col0;
#pragma unroll
                for (int bj = 0; bj < 2; ++bj) { float f[8]; unpack8(xb[m][bj], f);
                    const f32x4 v0 = acc[ai][bj][m][0], v1 = acc[ai][bj][m][1];
                    u32x4 w; w.x = pk2(f[0] + v0[0], f[1] + v0[1]); w.y = pk2(f[2] + v0[2], f[3] + v0[3]); w.z = pk2(f[4] + v1[0], f[5] + v1[1]); w.w = pk2(f[6] + v1[2], f[7] + v1[3]);
                    *(u32x4*)(rowp + bj * HALF) = w; } }
            __builtin_amdgcn_sched_barrier(0); }
    }
};
struct EpiMerged {
    static constexpr bool PERM = true, AFTER_DRAIN = false, MID = true;
    bf16_t* O; const bf16_t* G;
    __device__ __forceinline__ void mid(f32x4 (&acc)[2][2][4][2], const Unit& u, int b, int wr, int wc, int fr, int fq) const {
        int row0 = u.pm * BM + wr * 64 + fr, col0 = u.pn * BM + wc * 32 + 8 * fq;
        asm volatile("" : "+v"(row0), "+v"(col0));
        u32x2 ga[2][4][2], gb[2][4][2];
#pragma unroll
        for (int ai = 0; ai < 2; ++ai)
#pragma unroll
            for (int m = 0; m < 4; ++m) { const unsigned char* gp = (const unsigned char*)(G + (size_t)(row0 + ai * HALF + m * 16) * NPJ) + b * DM + col0;
#pragma unroll
                for (int bj = 0; bj < 2; ++bj) { ga[ai][m][bj] = *(const u32x2*)(gp + bj * HALF); gb[ai][m][bj] = *(const u32x2*)(gp + DM + bj * HALF); } }
        __builtin_amdgcn_sched_barrier(0);
#pragma unroll
        for (int ai = 0; ai < 2; ++ai)
#pragma unroll
            for (int m = 0; m < 4; ++m)
#pragma unroll
                for (int bj = 0; bj < 2; ++bj) { float fa[8], fb[8]; ub8(ga[ai][m][bj], fa); ub8(gb[ai][m][bj], fb);
#pragma unroll
                    for (int j = 0; j < 4; ++j) { acc[ai][bj][m][0][j] *= fa[j] * frcp(fb[j]); acc[ai][bj][m][1][j] *= fa[4 + j] * frcp(fb[4 + j]); } }
        __builtin_amdgcn_sched_barrier(0);
    }
    __device__ __forceinline__ void operator()(f32x4 (&acc)[2][2][4][2], const Unit& u, int wr, int wc, int fr, int fq) const {
        const int row0 = u.pm * BM + wr * 64 + fr, col0 = u.pn * BM + wc * 32 + 8 * fq;
#pragma unroll
        for (int ai = 0; ai < 2; ++ai) { u32x2 ga[4][2];
#pragma unroll
            for (int m = 0; m < 4; ++m) { const unsigned char* gp = (const unsigned char*)(G + (size_t)(row0 + ai * HALF + m * 16) * NPJ) + 3 * DM + col0;
#pragma unroll
                for (int bj = 0; bj < 2; ++bj) ga[m][bj] = *(const u32x2*)(gp + bj * HALF); }
            __builtin_amdgcn_sched_barrier(0);
#pragma unroll
            for (int m = 0; m < 4; ++m) { bf16_t* rowp = O + (size_t)(row0 + ai * HALF + m * 16) * DM + col0;
#pragma unroll
                for (int bj = 0; bj < 2; ++bj) { float fa[8]; ub8(ga[m][bj], fa);
#pragma unroll
                    for (int j = 0; j < 8; ++j) fa[j] *= (1.0f / 255.0f);
                    const f32x4 v0 = acc[ai][bj][m][0], v1 = acc[ai][bj][m][1];
                    u32x4 w; w.x = pk2(v0[0] * fa[0], v0[1] * fa[1]); w.y = pk2(v0[2] * fa[2], v0[3] * fa[3]); w.z = pk2(v1[0] * fa[4], v1[1] * fa[5]); w.w = pk2(v1[2] * fa[6], v1[3] * fa[7]);
                    *(u32x4*)(rowp + bj * HALF) = w; } }
            __builtin_amdgcn_sched_barrier(0); }
    }
};

struct EpiAny {
    int mode;
    bf16_t* O; const bf16_t* G; bf16_t* X;
    __device__ __forceinline__ bool perm() const { return true; }
    __device__ __forceinline__ bool wide() const { return mode == 0; }
    __device__ __forceinline__ void mid(f32x4 (&acc)[2][2][4][2], const Unit& u, int b, int wr, int wc, int fr, int fq) const { EpiMerged E{O, G}; E.mid(acc, u, b, wr, wc, fr, fq); }
    __device__ __forceinline__ void operator()(f32x4 (&acc)[2][2][4][2], const Unit& u, int wr, int wc, int fr, int fq) const {
        if (mode == 0) { EpiProj E{O}; E(acc, u, wr, wc, fr, fq); }
        else if (mode == 1) { EpiMerged E{O, G}; E(acc, u, wr, wc, fr, fq); }
        else if (mode == 2) { EpiResid E{X}; E(acc, u, wr, wc, fr, fq); }
        else { EpiSwiGLU E{O}; E(acc, u, wr, wc, fr, fq); }
    }
};

template <class Epi, class Sched>
__device__ __forceinline__ void gemm_phase(PG8_LAS unsigned char* lds, const Gemm g, const Sched& S, const Epi& E, const int tid) {
    const int wid = __builtin_amdgcn_readfirstlane(tid >> 6), lane = tid & 63, wr = wid >> 2, wc = wid & 3, fr = lane & 15, fq = lane >> 4;
    const int K = g.K, nt = K / BK;
    unsigned voffA[2], voffB[2];
#pragma unroll
    for (int i = 0; i < 2; ++i) { int R, C; stage_rc(tid * 16 + i * 8192, R, C); const int Rb = E.wide() ? 64 * (R >> 5) + perm32(R & 31) : E.perm() ? ((R & ~31) + perm32(R & 31)) : R;
        voffA[i] = (unsigned)(R * K + C) * 2u; voffB[i] = (unsigned)(Rb * K + C) * 2u; }
    const size_t kstep = (size_t)(BK * 2);
    const size_t hstep = (size_t)HALF * K * 2;
    const size_t tstep = 2 * hstep;
    const size_t hstepB = E.wide() ? (size_t)32 * K * 2 : hstep;
    const unsigned ldsw = (unsigned)wid * 1024u;
    const int aoff = lds_byte(wr * 64 + fr, fq * 8), boff = lds_byte(wc * 32 + fr, fq * 8);
#define PG8_SA(b, h) (((b) * 2 + (h)) * HTB)
#define PG8_SB(b, h) ((4 + (b) * 2 + (h)) * HTB)
#define PG8_STAGE(bufoff, gbase, voff) do { _Pragma("unroll") for (int _i = 0; _i < 2; ++_i) \
        __builtin_amdgcn_global_load_lds((const unsigned*)((const char*)(gbase) + (voff)[_i]), (PG8_LAS unsigned*)(lds + (bufoff) + ldsw + _i * 8192), 16, 0, 0); } while (0)
#define PG8_LDA(dst, b, h) do { _Pragma("unroll") for (int m = 0; m < 4; ++m) _Pragma("unroll") for (int k = 0; k < 2; ++k) dst[m][k] = *(const PG8_LAS bf16x8*)(lds + PG8_SA(b, h) + aoff + m * 2048 + k * 1024); } while (0)
#define PG8_LDB(dst, b, h) do { _Pragma("unroll") for (int n = 0; n < 2; ++n) _Pragma("unroll") for (int k = 0; k < 2; ++k) dst[n][k] = *(const PG8_LAS bf16x8*)(lds + PG8_SB(b, h) + boff + n * 2048 + k * 1024); } while (0)
#define PG8_MMA(ai, bj, At, Bt) do { __builtin_amdgcn_s_setprio(1); _Pragma("unroll") for (int m = 0; m < 4; ++m) _Pragma("unroll") for (int n = 0; n < 2; ++n) _Pragma("unroll") for (int k = 0; k < 2; ++k) \
        acc[ai][bj][m][n] = __builtin_amdgcn_mfma_f32_16x16x32_bf16(Bt[n][k], At[m][k], acc[ai][bj][m][n], 0, 0, 0); __builtin_amdgcn_s_setprio(0); } while (0)
#define PG8_WAIT_V(n) asm volatile("s_waitcnt vmcnt(" #n ")" ::: "memory")
#define PG8_WAIT_L(n) asm volatile("s_waitcnt lgkmcnt(" #n ")" ::: "memory")
#define PG8_BAR __builtin_amdgcn_s_barrier()
#define PG8_SCHED __builtin_amdgcn_sched_barrier(0)
    Unit cur, nxt; int ui = 0;
    if (!S.next(0, cur)) return;
    f32x4 acc[2][2][4][2];
#pragma unroll
    for (int a = 0; a < 2; ++a)
#pragma unroll
        for (int b = 0; b < 2; ++b)
#pragma unroll
            for (int m = 0; m < 4; ++m)
#pragma unroll
                for (int n = 0; n < 2; ++n) acc[a][b][m][n] = (f32x4){0.f, 0.f, 0.f, 0.f};
    bf16x8 At[4][2], B0[2][2], B1[2][2];
    const char* cA = (const char*)g.A + (size_t)cur.pm * tstep; const char* cB = (const char*)g.Bt + (size_t)cur.pn * tstep;
    S.a_ready(cur);
    PG8_STAGE(PG8_SB(0, 0), cB, voffB); PG8_STAGE(PG8_SB(0, 1), cB + hstepB, voffB); PG8_STAGE(PG8_SA(0, 0), cA, voffA); PG8_STAGE(PG8_SA(0, 1), cA + hstep, voffA);
    if (wr == 1) PG8_BAR;
    PG8_WAIT_V(2); PG8_BAR;
    PG8_STAGE(PG8_SB(1, 0), cB + kstep, voffB); PG8_STAGE(PG8_SA(1, 0), cA + kstep, voffA); PG8_STAGE(PG8_SB(1, 1), cB + hstepB + kstep, voffB);
    PG8_WAIT_V(6); PG8_BAR;
    for (;;) {
        const bool has_next = S.next(ui + 1, nxt);
        const char* nA = has_next ? (const char*)g.A + (size_t)nxt.pm * tstep : cA; const char* nB = has_next ? (const char*)g.Bt + (size_t)nxt.pn * tstep : cB;
        for (int t = 0; t < nt; t += 2) {
            const bool last = (t == nt - 2);
            const char* a1 = cA + (size_t)(t + 1) * kstep;
            const char* a2 = last ? nA : cA + (size_t)(t + 2) * kstep; const char* b2 = last ? nB : cB + (size_t)(t + 2) * kstep;
            const char* a3 = a2 + kstep; const char* b3 = b2 + kstep;
            if (last && has_next) S.a_ready(nxt);
            PG8_LDB(B0, 0, 0); PG8_LDB(B1, 0, 1); PG8_SCHED; PG8_LDA(At, 0, 0); PG8_STAGE(PG8_SA(1, 1), a1 + hstep, voffA);
            PG8_WAIT_V(8); PG8_WAIT_L(0); PG8_BAR; PG8_MMA(0, 0, At, B0); PG8_MMA(0, 1, At, B1); PG8_BAR; PG8_SCHED;
            PG8_LDA(At, 0, 1); PG8_STAGE(PG8_SB(0, 0), b2, voffB); PG8_STAGE(PG8_SB(0, 1), b2 + hstepB, voffB); PG8_STAGE(PG8_SA(0, 0), a2, voffA);
            PG8_WAIT_V(8); PG8_WAIT_L(0); PG8_BAR; PG8_MMA(1, 0, At, B0); PG8_MMA(1, 1, At, B1); PG8_BAR; PG8_SCHED;
            PG8_LDB(B0, 1, 0); PG8_LDB(B1, 1, 1); PG8_SCHED; PG8_LDA(At, 1, 0); PG8_STAGE(PG8_SA(0, 1), a2 + hstep, voffA);
            PG8_WAIT_V(8); PG8_WAIT_L(0); PG8_BAR; PG8_MMA(0, 0, At, B0); PG8_MMA(0, 1, At, B1); PG8_BAR; PG8_SCHED;
            PG8_LDA(At, 1, 1); PG8_STAGE(PG8_SB(1, 0), b3, voffB); PG8_STAGE(PG8_SB(1, 1), b3 + hstepB, voffB); PG8_STAGE(PG8_SA(1, 0), a3, voffA);
            PG8_WAIT_V(8); PG8_WAIT_L(0); PG8_BAR; PG8_MMA(1, 0, At, B0); PG8_MMA(1, 1, At, B1); PG8_BAR; PG8_SCHED;
            if (E.mode == 1 && !last && ((t + 2) & 7) == 0) E.mid(acc, cur, ((t + 2) >> 3) - 1, wr, wc, fr, fq);
        }
        if (wr == 0) PG8_BAR;
        E(acc, cur, wr, wc, fr, fq); S.done(cur);
        if (!has_next) break;
#pragma unroll
        for (int a = 0; a < 2; ++a)
#pragma unroll
            for (int b = 0; b < 2; ++b)
#pragma unroll
                for (int m = 0; m < 4; ++m)
#pragma unroll
                    for (int n = 0; n < 2; ++n) acc[a][b][m][n] = (f32x4){0.f, 0.f, 0.f, 0.f};
        cur = nxt; cA = nA; cB = nB; ++ui;
        if (wr == 1) PG8_BAR;
    }
    PG8_WAIT_V(0);
    PG8_BAR;
#undef PG8_SA
#undef PG8_SB
#undef PG8_STAGE
#undef PG8_LDA
#undef PG8_LDB
#undef PG8_MMA
#undef PG8_WAIT_V
#undef PG8_WAIT_L
#undef PG8_BAR
#undef PG8_SCHED
}
}

#define XB_TMO      128
#define XB_XCNT(j)  (256  + 64 * (j))
#define XB_XSUB(j)  (1280 + 64 * (j))
#define XB_XGEN(j)  (2304 + 64 * (j))
#define XB_TOP      3328
#define XB_TOPGEN   3392
#define XCD_BAR_WORDS 3456
#define XB_SPIN_CAP (1u << 18)
__device__ __forceinline__ unsigned xb_ld(unsigned* p)              { return __hip_atomic_load(p, __ATOMIC_RELAXED, __HIP_MEMORY_SCOPE_AGENT); }
__device__ __forceinline__ unsigned xb_add(unsigned* p, unsigned v) { return __hip_atomic_fetch_add(p, v, __ATOMIC_RELAXED, __HIP_MEMORY_SCOPE_AGENT); }
__device__ __forceinline__ unsigned xb_xcc_id() { return (unsigned)__builtin_amdgcn_s_getreg((3 << 11) | 20) & 0xFu; }
#define XB_SPIN(cond, bar) do { unsigned _sp = 0; while (cond) { __builtin_amdgcn_s_sleep(1); \
    if ((++_sp & 255u) == 0u) { if (xb_ld(&(bar)[XB_TMO])) break; if (_sp > XB_SPIN_CAP) { atomicAdd(&(bar)[XB_TMO], 1u); break; } } } } while (0)
struct XcdBarrier { unsigned* bar; unsigned x; volatile LAS unsigned* st; };
__device__ __forceinline__ XcdBarrier xcd_barrier_post(unsigned* bar, volatile LAS unsigned* st) {
    XcdBarrier b; b.bar = bar; b.x = xb_xcc_id(); b.st = st;
    if (threadIdx.x == 0) (void)xb_add(&bar[XB_XCNT(b.x)], 1u);
    return b;
}
__device__ __forceinline__ void xcd_barrier_complete(unsigned* bar, unsigned x, unsigned& nloc, unsigned& nx) {
    const unsigned G = gridDim.x * gridDim.y * gridDim.z;
    unsigned sum, cnt, mine, sp = 0u;
    for (;;) {
        sum = 0u; cnt = 0u; mine = 0u;
#pragma unroll
        for (unsigned j = 0; j < 16; ++j) { const unsigned c = xb_ld(&bar[XB_XCNT(j)]); sum += c; cnt += (c > 0u) ? 1u : 0u; mine = (j == x) ? c : mine; }
        if (sum == G) break;
        __builtin_amdgcn_s_sleep(1);
        if ((++sp & 255u) == 0u) { if (xb_ld(&bar[XB_TMO])) break; if (sp > XB_SPIN_CAP) { atomicAdd(&bar[XB_TMO], 1u); break; } }
    }
    nloc = mine > 0u ? mine : 1u; nx = cnt > 0u ? cnt : 1u;
}
__device__ __forceinline__ void xcd_barrier(const XcdBarrier& b) {
    asm volatile("s_waitcnt vmcnt(0)" ::: "memory");
    __syncthreads();
    if (threadIdx.x == 0) {
        unsigned* bar = b.bar;
        __builtin_amdgcn_s_waitcnt(0);
        unsigned nloc = b.st[0], nx = b.st[1];
        if (nloc == 0u) { xcd_barrier_complete(bar, b.x, nloc, nx); b.st[0] = nloc; b.st[1] = nx; }
        const unsigned old = xb_add(&bar[XB_XSUB(b.x)], 1u);
        const unsigned gen = old / nloc;
        if (old + 1u == (gen + 1u) * nloc) {
            __builtin_amdgcn_fence(__ATOMIC_RELEASE, "agent");
            asm volatile("s_waitcnt vmcnt(0)" ::: "memory");
            const unsigned og = xb_add(&bar[XB_TOP], 1u);
            const unsigned tg = og / nx;
            if (og + 1u == (tg + 1u) * nx) xb_add(&bar[XB_TOPGEN], 1u);
            else XB_SPIN(xb_ld(&bar[XB_TOPGEN]) == tg, bar);
            __builtin_amdgcn_fence(__ATOMIC_ACQUIRE, "agent");
            xb_add(&bar[XB_XGEN(b.x)], 1u);
            asm volatile("s_waitcnt vmcnt(0)" ::: "memory");
        } else {
            XB_SPIN(xb_ld(&bar[XB_XGEN(b.x)]) == gen, bar);
            __builtin_amdgcn_fence(__ATOMIC_ACQUIRE, "agent");
            asm volatile("s_waitcnt vmcnt(0)" ::: "memory");
        }
    }
    __syncthreads();
}

struct Frame {
    LAS unsigned char* lds; int tid, lane, wave, G, c, gw;
    const float* const* in; float* out; unsigned char* ws;
};
#define WSP(T, off) ((T*)(F.ws + (off)))

__device__ __forceinline__ void tr_tile(const Frame& F, const float* __restrict__ src, int ldn, int k0, int n0, bf16_t* __restrict__ dst, size_t dld, int drow0, int dcol0) {
    LAS float* tile = (LAS float*)F.lds;
    const int tid = F.tid;
#pragma unroll
    for (int i = 0; i < 2; ++i) { const int r = (tid >> 4) + 32 * i, c4 = (tid & 15) * 4; const f32x4 v = *(const f32x4*)(src + (size_t)(k0 + r) * ldn + n0 + c4);
        tile[r * 65 + c4 + 0] = v[0]; tile[r * 65 + c4 + 1] = v[1]; tile[r * 65 + c4 + 2] = v[2]; tile[r * 65 + c4 + 3] = v[3]; }
    __syncthreads();
    { const int n = tid >> 3, kc = (tid & 7) * 8; float f[8];
#pragma unroll
      for (int e = 0; e < 8; ++e) f[e] = tile[(kc + e) * 65 + n];
      u32x4 w; w.x = pk2(f[0], f[1]); w.y = pk2(f[2], f[3]); w.z = pk2(f[4], f[5]); w.w = pk2(f[6], f[7]);
      *(u32x4*)(dst + (size_t)(drow0 + n) * dld + dcol0 + kc) = w; }
    __syncthreads();
}
template <int KIND>
__device__ __forceinline__ void tr_matrix(const Frame& F, const float* __restrict__ src, int K, int N, bf16_t* __restrict__ dst, size_t dld, int dcol_base, int rot) {
    const int nk = K / 64, nn = N / 64, ntile = nk * nn;
    for (int t = (F.c + rot) % F.G; t < ntile; t += F.G) {
        const int kt = t % nk, ntl = t / nk, k0 = kt * 64, n0 = ntl * 64; int drow0 = n0;
        if (KIND == 1) drow0 = n0 + (n0 >= RC ? 64 : 0);
        if (KIND == 2) { const int f = n0 < DFF ? n0 : n0 - DFF; drow0 = 256 * (f >> 7) + (f & 127) + (n0 < DFF ? 0 : 128); }
        tr_tile(F, src, N, k0, n0, dst, dld, drow0, dcol_base + k0);
    }
}
__device__ __forceinline__ void ph_prep(const Frame& F) {
    const size_t gt = (size_t)F.c * NTHR + F.tid, gs = (size_t)F.G * NTHR;
    int rot = 0;
    for (int l = 0; l < NL; ++l) {
        tr_matrix<1>(F, F.in[10] + (size_t)l * DM * INC, DM, INC, WSP(bf16_t, WS_WIN) + (size_t)l * NPJ * DM, DM, 0, rot); rot += 32 * 215;
        for (int br = 0; br < 4; ++br) { tr_matrix<0>(F, F.in[31] + (size_t)(l * 4 + br) * 512 * DM, 512, DM, WSP(bf16_t, WS_WBR) + (size_t)l * DM * DM, DM, br * 512, rot); rot += 8 * 32; }
        tr_matrix<0>(F, F.in[32] + (size_t)l * DM * DM, DM, DM, WSP(bf16_t, WS_WOUT) + (size_t)l * DM * DM, DM, 0, rot); rot += 32 * 32;
        tr_matrix<2>(F, F.in[33] + (size_t)l * DM * 2 * DFF, DM, 2 * DFF, WSP(bf16_t, WS_WFI) + (size_t)l * 2 * DFF * DM, DM, 0, rot); rot += 32 * 176;
        tr_matrix<0>(F, F.in[34] + (size_t)l * DFF * DM, DFF, DM, WSP(bf16_t, WS_WFO) + (size_t)l * DM * DFF, DFF, 0, rot); rot += 88 * 32;
    }
    { bf16_t* w2t = WSP(bf16_t, WS_W2T); bf16_t* a2t = WSP(bf16_t, WS_A2T); bf16_t* g2t = WSP(bf16_t, WS_G2T);
      for (size_t i = gt; i < (size_t)NL * 512 * 96; i += gs) { const int k = (int)(i % 96), n = (int)((i / 96) % 512), l = (int)(i / (96 * 512));
          w2t[i] = (bf16_t)(pk2(F.in[13][((size_t)l * 96 + k) * 512 + n], 0.f) & 0xffffu); a2t[i] = (bf16_t)(pk2(F.in[15][((size_t)l * 96 + k) * 512 + n], 0.f) & 0xffffu); }
      for (size_t i = gt; i < (size_t)NL * 512 * 256; i += gs) { const int k = (int)(i % 256), n = (int)((i / 256) % 512), l = (int)(i / (256 * 512));
          g2t[i] = (bf16_t)(pk2(F.in[16][((size_t)l * 256 + k) * 512 + n], 0.f) & 0xffffu); } }
    { bf16_t* wsb = WSP(bf16_t, WS_WSB);
      for (size_t i = gt; i < (size_t)NL * 8 * 128 * 128; i += gs) { const int j = (int)(i & 127), ii = (int)((i >> 7) & 127); wsb[i] = (bf16_t)(pk2(j <= ii ? F.in[24][i] : 0.f, 0.f) & 0xffffu); } }
    { u32x2* ck = WSP(u32x2, WS_CK); u32x2* cv = WSP(u32x2, WS_CVV); const f32x4* sk = (const f32x4*)F.in[5]; const f32x4* sv = (const f32x4*)F.in[6];
      for (size_t i = gt; i < (size_t)NL * SB * 512 * 512 / 4; i += gs) { const f32x4 a = sk[i], b = sv[i]; u32x2 wa, wb; wa.x = pk2(a[0], a[1]); wa.y = pk2(a[2], a[3]); wb.x = pk2(b[0], b[1]); wb.y = pk2(b[2], b[3]); ck[i] = wa; cv[i] = wb; } }
    { bf16_t* shs = WSP(bf16_t, WS_SHS);
      for (size_t i = gt; i < (size_t)NL * SB * 2048; i += gs) { const int cc = (int)(i & 2047); const size_t lb = i >> 11; shs[i] = cc < RC ? (bf16_t)(pk2(F.in[2][lb * RC + cc], 0.f) & 0xffffu) : (bf16_t)0; }
      bf16_t* zr = WSP(bf16_t, WS_ZROW); for (size_t i = gt; i < 2048; i += gs) zr[i] = (bf16_t)0; }
    { u32x4* z = WSP(u32x4, WS_WIN);
      for (size_t i = gt; i < (size_t)NL * 64 * DM * 2 / 16; i += gs) { const size_t l = i / (64 * DM * 2 / 16), r = i % (64 * DM * 2 / 16); z[(l * NPJ * DM * 2 + (size_t)RC * DM * 2) / 16 + r] = (u32x4){0u, 0u, 0u, 0u}; }
      u32x4* oc = (u32x4*)(F.ws + WS_OCAT + (size_t)MR * DM * 2);
      for (size_t i = gt; i < (size_t)(MP - MR) * DM * 2 / 16; i += gs) oc[i] = (u32x4){0u, 0u, 0u, 0u}; }
}

template <bool FINAL>
__device__ __forceinline__ void ph_rmsnorm(const Frame& F, const float* __restrict__ g, const bool from_inputs) {
    bf16_t* H = WSP(bf16_t, WS_H); bf16_t* XB = WSP(bf16_t, WS_X);
    const int nrow = FINAL ? MR : MP;
    for (int row = F.gw; row < nrow; row += F.G * NWAVE) {
        if (!FINAL && row >= MR) {
#pragma unroll
            for (int i = 0; i < 8; ++i) *(u32x2*)(H + (size_t)row * DM + i * 256 + F.lane * 4) = (u32x2){0u, 0u};
            continue; }
        f32x4 v[8]; float ss = 0.f;
        if (from_inputs) {
            const float* X = row < NPR ? F.in[0] : F.in[1] - (size_t)NPR * DM;
#pragma unroll
            for (int i = 0; i < 8; ++i) v[i] = *(const f32x4*)(X + (size_t)row * DM + i * 256 + F.lane * 4);
#pragma unroll
            for (int i = 0; i < 8; ++i) { u32x2 w; w.x = pk2(v[i][0], v[i][1]); w.y = pk2(v[i][2], v[i][3]); *(u32x2*)(XB + (size_t)row * DM + i * 256 + F.lane * 4) = w; }
        } else {
            u32x2 xr[8];
#pragma unroll
            for (int i = 0; i < 8; ++i) xr[i] = *(const u32x2*)(XB + (size_t)row * DM + i * 256 + F.lane * 4);
#pragma unroll
            for (int i = 0; i < 8; ++i) v[i] = (f32x4){bflo(xr[i].x), bfhi(xr[i].x), bflo(xr[i].y), bfhi(xr[i].y)};
        }
#pragma unroll
        for (int i = 0; i < 8; ++i) ss += v[i][0] * v[i][0] + v[i][1] * v[i][1] + v[i][2] * v[i][2] + v[i][3] * v[i][3];
        ss = wave_sum(ss);
        const float sc = __builtin_amdgcn_rsqf(ss * (1.0f / DM) + 1e-6f);
#pragma unroll
        for (int i = 0; i < 8; ++i) { const f32x4 gg = *(const f32x4*)(g + i * 256 + F.lane * 4); const f32x4 o = v[i] * sc * gg;
            if (FINAL) { float* dst = row < NPR ? F.out + O_YP + (size_t)row * DM : F.out + O_YS + (size_t)(row - NPR) * DM; *(f32x4*)(dst + i * 256 + F.lane * 4) = o; }
            else { u32x2 w; w.x = pk2(o[0], o[1]); w.y = pk2(o[2], o[3]); *(u32x2*)(H + (size_t)row * DM + i * 256 + F.lane * 4) = w; } }
    }
}

struct Sh8 { u32x4 p, q; f32x4 m0, m1; };
__device__ __forceinline__ Sh8 shift8_ld(const bf16_t* prow, const bf16_t* pprev, const float* mu, int col) { Sh8 r; r.p = *(const u32x4*)(prow + col); r.q = *(const u32x4*)(pprev + col); r.m0 = *(const f32x4*)(mu + col); r.m1 = *(const f32x4*)(mu + col + 4); return r; }
__device__ __forceinline__ void shift8_do(const Sh8& r, float (&xs)[8]) {
    float p[8], q[8]; unpack8(r.p, p); unpack8(r.q, q);
#pragma unroll
    for (int e = 0; e < 4; ++e) { xs[e] = p[e] + r.m0[e] * (q[e] - p[e]); xs[4 + e] = p[4 + e] + r.m1[e] * (q[4 + e] - p[4 + e]); }
}
__device__ __forceinline__ void shift8(const bf16_t* prow, const bf16_t* pprev, const float* mu, int col, float (&xs)[8]) {
    float p[8], q[8]; unpack8(*(const u32x4*)(prow + col), p); unpack8(*(const u32x4*)(pprev + col), q);
    const f32x4 m0 = *(const f32x4*)(mu + col), m1 = *(const f32x4*)(mu + col + 4);
#pragma unroll
    for (int e = 0; e < 4; ++e) { xs[e] = p[e] + m0[e] * (q[e] - p[e]); xs[4 + e] = p[4 + e] + m1[e] * (q[4 + e] - p[4 + e]); }
}
__device__ __forceinline__ void shift4(const bf16_t* prow, const bf16_t* pprev, const float* mu, int col, float (&xs)[4]) {
    const u32x2 w = *(const u32x2*)(prow + col), z = *(const u32x2*)(pprev + col); const float p[4] = {bflo(w.x), bfhi(w.x), bflo(w.y), bfhi(w.y)}, q[4] = {bflo(z.x), bfhi(z.x), bflo(z.y), bfhi(z.y)};
    const f32x4 m = *(const f32x4*)(mu + col);
#pragma unroll
    for (int e = 0; e < 4; ++e) xs[e] = p[e] + m[e] * (q[e] - p[e]);
}
__device__ __forceinline__ bf16x8 pack_frag(const float (&f)[8]) { u32x4 w; w.x = pk2(f[0], f[1]); w.y = pk2(f[2], f[3]); w.z = pk2(f[4], f[5]); w.w = pk2(f[6], f[7]); return __builtin_bit_cast(bf16x8, w); }

__device__ __forceinline__ void rwkv_prep_unit(const Frame& F, int l, int tt, int hd_lo, int nh) {
    asm volatile("s_waitcnt vmcnt(0)" ::: "memory");
    int lane = F.lane;
    asm volatile("" : "+v"(lane));
    const int c16 = lane & 15, qd = lane >> 4;
    const int tok = tt * 16 + c16;
    const bf16_t* PJ = WSP(bf16_t, WS_PROJ);
    const bf16_t* prow = PJ + (size_t)tok * NPJ;
    const bool first = tok < NPR ? (tok % SEQ == 0) : ((tok - NPR) % ST == 0);
    const bf16_t* pprev = !first ? prow - NPJ : (tok >= NPR ? WSP(bf16_t, WS_SHS) + ((size_t)l * SB + (tok - NPR) / ST) * 2048 : WSP(bf16_t, WS_ZROW));
    const float* mu = F.in[11] + (size_t)l * RC;
    bf16x8 fw[3], fa[3];
    { Sh8 lw[3], la[3];
#pragma unroll
      for (int ks = 0; ks < 3; ++ks) { lw[ks] = shift8_ld(prow, pprev, mu, 1536 + 32 * ks + 8 * qd); la[ks] = shift8_ld(prow, pprev, mu, 1632 + 32 * ks + 8 * qd); }
      __builtin_amdgcn_sched_barrier(0);
#pragma unroll
      for (int ks = 0; ks < 3; ++ks) { float xs[8]; shift8_do(lw[ks], xs);
#pragma unroll
          for (int e = 0; e < 8; ++e) xs[e] = ftanh(xs[e]);
          fw[ks] = pack_frag(xs); shift8_do(la[ks], xs); fa[ks] = pack_frag(xs); } }
    __builtin_amdgcn_sched_barrier(0);
    const bf16_t* W2T = WSP(bf16_t, WS_W2T) + (size_t)l * 512 * 96; const bf16_t* A2T = WSP(bf16_t, WS_A2T) + (size_t)l * 512 * 96;
    const float* w0 = F.in[12] + l * 512; const float* a0 = F.in[14] + l * 512; const float* kkw = F.in[17] + l * 512; const float* kaw = F.in[18] + l * 512; const float* rkw = F.in[19] + l * 512;
    bf16_t* SV = (bf16_t*)(WSP(float, WS_SCAN) + 3 * (size_t)MR * 512);
    float* BON = WSP(float, WS_BON);
    LAS unsigned char* wl = F.lds + F.wave * 8192;
#define DPP_SHR1(x, n) __int_as_float(__builtin_amdgcn_update_dpp(0x3f800000, __float_as_int(x), 0x110 + (n), 0xF, 0xF, false))
#pragma unroll 1
    for (int hd = hd_lo; hd < hd_lo + nh; ++hd) {
        asm volatile("s_waitcnt vmcnt(0)" ::: "memory");
        int lq = lane; asm volatile("" : "+v"(lq));
        const int c16h = lq & 15, qdh = lq >> 4;
        unsigned char* rec = F.ws + WS_REC + ((size_t)tt * 8 + hd) * REC_BYTES + (size_t)lq * 16;
        float ss = 0.f, bon = 0.f;
        bf16x8 pbw[3], pba[3]; u32x2 ppc[3], ppq[3];
#define RW_ISSUE(nt_) do { const int n_ = hd * 64 + (nt_) * 16 + c16h, col_ = hd * 64 + (nt_) * 16 + 4 * qdh; \
            _Pragma("unroll") for (int k3 = 0; k3 < 3; ++k3) { pbw[k3] = *(const bf16x8*)(W2T + (size_t)n_ * 96 + 32 * k3 + 8 * qdh); pba[k3] = *(const bf16x8*)(A2T + (size_t)n_ * 96 + 32 * k3 + 8 * qdh); } \
            _Pragma("unroll") for (int sg = 0; sg < 3; ++sg) { ppc[sg] = *(const u32x2*)(prow + sg * 512 + col_); ppq[sg] = *(const u32x2*)(pprev + sg * 512 + col_); } } while (0)
        { u32x2 kc[4], kq[4]; f32x4 mk[4], kw4[4];
#pragma unroll
          for (int nt = 0; nt < 4; ++nt) { const int col = hd * 64 + nt * 16 + 4 * qdh; kc[nt] = *(const u32x2*)(prow + 512 + col); kq[nt] = *(const u32x2*)(pprev + 512 + col); mk[nt] = *(const f32x4*)(mu + 512 + col); kw4[nt] = *(const f32x4*)(kkw + col); }
          RW_ISSUE(0);
          __builtin_amdgcn_sched_barrier(0);
#pragma unroll
          for (int nt = 0; nt < 4; ++nt) { const float p[4] = {bflo(kc[nt].x), bfhi(kc[nt].x), bflo(kc[nt].y), bfhi(kc[nt].y)}, q[4] = {bflo(kq[nt].x), bfhi(kq[nt].x), bflo(kq[nt].y), bfhi(kq[nt].y)};
#pragma unroll
              for (int j = 0; j < 4; ++j) { const float kx = (p[j] + mk[nt][j] * (q[j] - p[j])) * kw4[nt][j]; ss += kx * kx; } } }
        ss += __shfl_xor(ss, 16); ss += __shfl_xor(ss, 32);
        const float inv = __builtin_amdgcn_rsqf(fmaxf(ss, 1e-24f));
        __builtin_amdgcn_sched_barrier(0);
        f32x4 Lb = (f32x4){0.f, 0.f, 0.f, 0.f}, Lk = Lb, Mb = Lb, Mk = Lb;
#pragma unroll
        for (int ks = 0; ks < 2; ++ks) {
            float rr[2][4], ww[2][4], km[2][4], aa[2][4], bb[2][4];
#pragma unroll
            for (int n2 = 0; n2 < 2; ++n2) { const int nt = 2 * ks + n2;
                f32x4 accw = (f32x4){0.f, 0.f, 0.f, 0.f}, acca = accw;
                const int n = hd * 64 + nt * 16 + c16h;
                const int col = hd * 64 + nt * 16 + 4 * qdh;
                bf16x8 bw[3], ba[3]; u32x2 pcn[3], pqn[3];
#pragma unroll
                for (int k3 = 0; k3 < 3; ++k3) { bw[k3] = pbw[k3]; ba[k3] = pba[k3]; pcn[k3] = ppc[k3]; pqn[k3] = ppq[k3]; }
                const f32x4 m0 = *(const f32x4*)(mu + col), m1 = *(const f32x4*)(mu + 512 + col), m2 = *(const f32x4*)(mu + 1024 + col);
                const f32x4 w0v = *(const f32x4*)(w0 + col), a0v = *(const f32x4*)(a0 + col), kkv = *(const f32x4*)(kkw + col), kav = *(const f32x4*)(kaw + col), rkv = *(const f32x4*)(rkw + col);
                if (nt < 3) RW_ISSUE(nt + 1);
                __builtin_amdgcn_sched_barrier(0);
#pragma unroll
                for (int k3 = 0; k3 < 3; ++k3) { accw = __builtin_amdgcn_mfma_f32_16x16x32_bf16(bw[k3], fw[k3], accw, 0, 0, 0); acca = __builtin_amdgcn_mfma_f32_16x16x32_bf16(ba[k3], fa[k3], acca, 0, 0, 0); }
                float vvn[4];
                { const u32x2 a = pcn[0], b = pqn[0], c = pcn[1], d = pqn[1], e = pcn[2], f = pqn[2];
                  const float p0[4] = {bflo(a.x), bfhi(a.x), bflo(a.y), bfhi(a.y)}, q0[4] = {bflo(b.x), bfhi(b.x), bflo(b.y), bfhi(b.y)};
                  const float p1[4] = {bflo(c.x), bfhi(c.x), bflo(c.y), bfhi(c.y)}, q1[4] = {bflo(d.x), bfhi(d.x), bflo(d.y), bfhi(d.y)};
                  const float p2[4] = {bflo(e.x), bfhi(e.x), bflo(e.y), bfhi(e.y)}, q2[4] = {bflo(f.x), bfhi(f.x), bflo(f.y), bfhi(f.y)};
#pragma unroll
                  for (int j = 0; j < 4; ++j) { rr[n2][j] = p0[j] + m0[j] * (q0[j] - p0[j]); km[n2][j] = p1[j] + m1[j] * (q1[j] - p1[j]); vvn[j] = p2[j] + m2[j] * (q2[j] - p2[j]); } }
#pragma unroll
                for (int j = 0; j < 4; ++j) { ww[n2][j] = fexp(-0.60653065971f * sigm(w0v[j] + accw[j])); const float asig = sigm(a0v[j] + acca[j]);
                    const float k = km[n2][j], kn = k * kkv[j] * inv; aa[n2][j] = -kn; bb[n2][j] = kn * asig;
                    const float kmod = k * (1.0f + (asig - 1.0f) * kav[j]); km[n2][j] = kmod; bon += rr[n2][j] * kmod * rkv[j]; }
                { u32x2 wv; wv.x = pk2(vvn[0], vvn[1]); wv.y = pk2(vvn[2], vvn[3]); *(u32x2*)(SV + (size_t)tok * 512 + col) = wv; }
#pragma unroll
                for (int j = 0; j < 4; ++j) *(LAS bf16_t*)(wl + 5120 + (16 * nt + 4 * qdh + j) * 40 + c16h * 2) = (bf16_t)(pk2(vvn[j], 0.f) & 0xffffu);
                __builtin_amdgcn_sched_barrier(0);
            }
#pragma unroll
            for (int n2 = 0; n2 < 2; ++n2) { const int nt = 2 * ks + n2;
#pragma unroll
                for (int j = 0; j < 4; ++j) {
                    float g = ww[n2][j];
                    g *= DPP_SHR1(g, 1); g *= DPP_SHR1(g, 2); g *= DPP_SHR1(g, 4); g *= DPP_SHR1(g, 8);
                    const float gex = DPP_SHR1(g, 1), gi = frcp(g);
                    ww[n2][j] = g;
                    aa[n2][j] *= gex;
                    bb[n2][j] *= gi;
                    km[n2][j] *= gi;
                    rr[n2][j] *= g;
                    const int key = 16 * nt + 4 * qdh + j; const unsigned pb = pk2(bb[n2][j], km[n2][j]);
                    *(LAS bf16_t*)(wl + key * 40 + c16h * 2) = (bf16_t)(pb & 0xffffu); *(LAS bf16_t*)(wl + 2560 + key * 40 + c16h * 2) = (bf16_t)(pb >> 16);
                }
                if (c16h == 15) *(f32x4*)(rec - (size_t)lq * 16 + REC_G16 + (16 * nt + 4 * qdh) * 4) = (f32x4){ww[n2][0], ww[n2][1], ww[n2][2], ww[n2][3]};
            }
            const float xa[8] = {aa[0][0], aa[0][1], aa[0][2], aa[0][3], aa[1][0], aa[1][1], aa[1][2], aa[1][3]};
            const float xr[8] = {rr[0][0], rr[0][1], rr[0][2], rr[0][3], rr[1][0], rr[1][1], rr[1][2], rr[1][3]};
            const float xb[8] = {bb[0][0], bb[0][1], bb[0][2], bb[0][3], bb[1][0], bb[1][1], bb[1][2], bb[1][3]};
            const float xk[8] = {km[0][0], km[0][1], km[0][2], km[0][3], km[1][0], km[1][1], km[1][2], km[1][3]};
            const bf16x8 fA = pack_frag(xa), fR = pack_frag(xr), fB = pack_frag(xb), fK = pack_frag(xk);
            *(bf16x8*)(rec + (0 + ks) * 1024) = fA; *(bf16x8*)(rec + (2 + ks) * 1024) = fR;
            Lb = __builtin_amdgcn_mfma_f32_16x16x32_bf16(fB, fA, Lb, 0, 0, 0); Lk = __builtin_amdgcn_mfma_f32_16x16x32_bf16(fK, fA, Lk, 0, 0, 0);
            Mb = __builtin_amdgcn_mfma_f32_16x16x32_bf16(fB, fR, Mb, 0, 0, 0); Mk = __builtin_amdgcn_mfma_f32_16x16x32_bf16(fK, fR, Mk, 0, 0, 0);
            __builtin_amdgcn_sched_barrier(0);
        }
        bon += __shfl_xor(bon, 16); bon += __shfl_xor(bon, 32);
        if (qdh == 0) BON[(size_t)tok * 8 + hd] = bon;
#pragma unroll
        for (int j = 0; j < 4; ++j) { const int sidx = 4 * qdh + j; if (!(sidx < c16h)) { Lb[j] = 0.f; Lk[j] = 0.f; } if (!(sidx <= c16h)) { Mb[j] = 0.f; Mk[j] = 0.f; } }
        { const float xl[8] = {Lk[0], Lk[1], Lk[2], Lk[3], 0.f, 0.f, 0.f, 0.f}; *(bf16x8*)(rec + 4 * 1024) = pack_frag(xl);
          const float xm[8] = {Mb[0], Mb[1], Mb[2], Mb[3], Mk[0], Mk[1], Mk[2], Mk[3]}; *(bf16x8*)(rec + 6 * 1024) = pack_frag(xm); }
        { float Lf[16], Tc[16];
#pragma unroll
          for (int f = 0; f < 4; ++f)
#pragma unroll
              for (int j = 0; j < 4; ++j) Lf[4 * f + j] = __shfl(Lb[j], c16h + 16 * f);
#pragma unroll
          for (int sI = 0; sI < 16; ++sI) Tc[sI] = (sI == c16h) ? 1.0f : 0.0f;
#pragma unroll
          for (int m = 0; m < 15; ++m) {
#pragma unroll
              for (int sI = 0; sI <= m; ++sI) Tc[sI] += __int_as_float(__builtin_amdgcn_readlane(__float_as_int(Tc[sI]), m)) * Lf[m]; }
          float xt[8];
#pragma unroll
          for (int e = 0; e < 4; ++e) { xt[e] = qdh == 0 ? Tc[e] : qdh == 1 ? Tc[4 + e] : qdh == 2 ? Tc[8 + e] : Tc[12 + e]; xt[4 + e] = 0.f; }
          *(bf16x8*)(rec + 5 * 1024) = pack_frag(xt); }
        asm volatile("s_waitcnt lgkmcnt(0)" ::: "memory");
#pragma unroll
        for (int kt = 0; kt < 4; ++kt) { const int rowo = (16 * kt + c16h) * 40 + 8 * qdh;
            const u32x2 b4 = *(const LAS u32x2*)(wl + rowo), k4 = *(const LAS u32x2*)(wl + 2560 + rowo), v4 = *(const LAS u32x2*)(wl + 5120 + rowo);
            *(u32x4*)(rec + (7 + kt) * 1024) = (u32x4){b4.x, b4.y, k4.x, k4.y};
            *(u32x2*)(rec - (size_t)lq * 8 + REC_FV + kt * 512) = v4; }
        asm volatile("s_waitcnt lgkmcnt(0)" ::: "memory");
    }
#undef DPP_SHR1
#undef RW_ISSUE
}

__device__ __forceinline__ void rwkv_gate_unit(const Frame& F, int l, int tt, int t_lo, int nt16) {
    asm volatile("s_waitcnt vmcnt(0)" ::: "memory");
    int lane = F.lane;
    asm volatile("" : "+v"(lane));
    const int c16 = lane & 15, qd = lane >> 4;
    const int tok = tt * 16 + c16;
    const bf16_t* prow = WSP(bf16_t, WS_PROJ) + (size_t)tok * NPJ;
    const bool first = tok < NPR ? (tok % SEQ == 0) : ((tok - NPR) % ST == 0);
    const bf16_t* pprev = !first ? prow - NPJ : (tok >= NPR ? WSP(bf16_t, WS_SHS) + ((size_t)l * SB + (tok - NPR) / ST) * 2048 : WSP(bf16_t, WS_ZROW));
    const float* mu = F.in[11] + (size_t)l * RC;
    bf16x8 fg[8];
#pragma unroll
    for (int hb = 0; hb < 2; ++hb) { Sh8 lg[4];
#pragma unroll
      for (int ks = 0; ks < 4; ++ks) lg[ks] = shift8_ld(prow, pprev, mu, 1728 + 32 * (4 * hb + ks) + 8 * qd);
      __builtin_amdgcn_sched_barrier(0); asm volatile("s_waitcnt vmcnt(0)" ::: "memory"); __builtin_amdgcn_sched_barrier(0);
#pragma unroll
      for (int ks = 0; ks < 4; ++ks) { float xs[8]; shift8_do(lg[ks], xs);
#pragma unroll
          for (int e = 0; e < 8; ++e) xs[e] = sigm(xs[e]);
          fg[4 * hb + ks] = pack_frag(xs); }
      __builtin_amdgcn_sched_barrier(0); }
    const bf16_t* G2T = WSP(bf16_t, WS_G2T) + (size_t)l * 512 * 256; bf16_t* GG = WSP(bf16_t, WS_G);
    for (int t16 = t_lo; t16 < t_lo + nt16; t16 += 4) {
        f32x4 accg[4]; bf16x8 bg[4][8];
#pragma unroll
        for (int u = 0; u < 4; ++u) { accg[u] = (f32x4){0.f, 0.f, 0.f, 0.f}; const int n = (t16 + u) * 16 + c16;
#pragma unroll
            for (int ks = 0; ks < 8; ++ks) bg[u][ks] = *(const bf16x8*)(G2T + (size_t)n * 256 + 32 * ks + 8 * qd); }
        __builtin_amdgcn_sched_barrier(0); asm volatile("s_waitcnt vmcnt(0)" ::: "memory"); __builtin_amdgcn_sched_barrier(0);
#pragma unroll
        for (int u = 0; u < 4; ++u)
#pragma unroll
            for (int ks = 0; ks < 8; ++ks) accg[u] = __builtin_amdgcn_mfma_f32_16x16x32_bf16(bg[u][ks], fg[ks], accg[u], 0, 0, 0);
        __builtin_amdgcn_sched_barrier(0);
#pragma unroll
        for (int u = 0; u < 4; ++u) { u32x2 wg; wg.x = pk2(accg[u][0], accg[u][1]); wg.y = pk2(accg[u][2], accg[u][3]); *(u32x2*)(GG + (size_t)tok * 512 + (t16 + u) * 16 + 4 * qd) = wg; }
        __builtin_amdgcn_sched_barrier(0);
    }
}

constexpr int GV_PITCH = 1040;
__device__ __forceinline__ void gmlp_unit(const Frame& F, int l, int unit) {
    asm volatile("s_waitcnt vmcnt(0)" ::: "memory");
    const int lane = F.lane, w = F.wave, c16 = lane & 15, qd = lane >> 4;
    const bool samp = unit >= 128; const int tokbase = samp ? NPR + (unit - 128) * ST : unit * 128, ntok = samp ? ST : 128;
    const bf16_t* PJ = WSP(bf16_t, WS_PROJ);
    const float* lnw = F.in[22] + l * 512; const float* lnb = F.in[23] + l * 512;
    LAS unsigned char* vimg = F.lds;
    { const f32x4 g0 = *(const f32x4*)(lnw + lane * 8), g1 = *(const f32x4*)(lnw + lane * 8 + 4), b0 = *(const f32x4*)(lnb + lane * 8), b1 = *(const f32x4*)(lnb + lane * 8 + 4);
      for (int t4 = w * 16; t4 < w * 16 + 16; t4 += 4) {
        if (t4 < ntok) {
            u32x4 raw[4];
#pragma unroll
            for (int u = 0; u < 4; ++u) raw[u] = *(const u32x4*)(PJ + (size_t)(tokbase + t4 + u) * NPJ + GM_OFF + 512 + lane * 8);
            __builtin_amdgcn_sched_barrier(0);
#pragma unroll
            for (int u = 0; u < 4; ++u) { const int tl = t4 + u;
                float x[8]; unpack8(raw[u], x); float s = 0.f;
#pragma unroll
                for (int e = 0; e < 8; ++e) { x[e] = gelu_t(x[e]); s += x[e]; }
                const float mean = wave_sum(s) * (1.0f / 512.0f); float q = 0.f;
#pragma unroll
                for (int e = 0; e < 8; ++e) { x[e] -= mean; q += x[e] * x[e]; }
                const float rstd = __builtin_amdgcn_rsqf(wave_sum(q) * (1.0f / 512.0f) + 1e-5f);
#pragma unroll
                for (int e = 0; e < 4; ++e) { x[e] = x[e] * rstd * g0[e] + b0[e]; x[4 + e] = x[4 + e] * rstd * g1[e] + b1[e]; }
                u32x4 pk; pk.x = pk2(x[0], x[1]); pk.y = pk2(x[2], x[3]); pk.z = pk2(x[4], x[5]); pk.w = pk2(x[6], x[7]);
                *(LAS u32x4*)(vimg + tl * GV_PITCH + lane * 16) = pk;
                if (samp) { float* o = F.out + O_SGV + (((size_t)l * SB + (unit - 128)) * ST + tl) * 512 + lane * 8; *(f32x4*)o = (f32x4){x[0], x[1], x[2], x[3]}; *(f32x4*)(o + 4) = (f32x4){x[4], x[5], x[6], x[7]}; } }
        } else if (t4 < 32) {
#pragma unroll
            for (int u = 0; u < 4; ++u) *(LAS u32x4*)(vimg + (t4 + u) * GV_PITCH + lane * 16) = (u32x4){0u, 0u, 0u, 0u}; }
      } }
    __syncthreads();
    { const int g = w; const bf16_t* W = WSP(bf16_t, WS_WSB) + ((size_t)l * 8 + g) * 128 * 128; const float* bs = F.in[25] + ((size_t)l * 8 + g) * 128;
      const int nks = samp ? 1 : 4, nit = samp ? 1 : 8;
      bf16x8 vf[4][4];
#pragma unroll
      for (int ks = 0; ks < 4; ++ks)
#pragma unroll
          for (int dt = 0; dt < 4; ++dt) { LAS unsigned char* a = vimg + (32 * ks + 8 * qd + (c16 >> 2)) * GV_PITCH + (g * 64 + 16 * dt + 4 * (c16 & 3)) * 2;
              vf[ks][dt] = cat8(lds_tr(a), lds_tr(a + 4 * GV_PITCH)); }
      for (int it = 0; it < nit; ++it) {
          f32x4 acc[4];
#pragma unroll
          for (int dt = 0; dt < 4; ++dt) acc[dt] = (f32x4){0.f, 0.f, 0.f, 0.f};
#pragma unroll
          for (int ks = 0; ks < 4; ++ks) if (ks < nks && ks <= (it >> 1)) { const bf16x8 wf = *(const bf16x8*)(W + (size_t)(16 * it + c16) * 128 + 32 * ks + 8 * qd);
#pragma unroll
              for (int dt = 0; dt < 4; ++dt) acc[dt] = __builtin_amdgcn_mfma_f32_16x16x32_bf16(vf[ks][dt], wf, acc[dt], 0, 0, 0); }
          const int tok = tokbase + 16 * it + c16; const float bsv = bs[16 * it + c16];
#pragma unroll
          for (int dt = 0; dt < 4; ++dt) { const int ch = g * 64 + 16 * dt + 4 * qd; const u32x2 uw = *(const u32x2*)(PJ + (size_t)tok * NPJ + GM_OFF + ch);
              const float u0 = gelu_t(bflo(uw.x)), u1 = gelu_t(bfhi(uw.x)), u2 = gelu_t(bflo(uw.y)), u3 = gelu_t(bfhi(uw.y));
              u32x2 o; o.x = pk2(u0 * (acc[dt][0] + bsv), u1 * (acc[dt][1] + bsv)); o.y = pk2(u2 * (acc[dt][2] + bsv), u3 * (acc[dt][3] + bsv));
              *(u32x2*)(WSP(bf16_t, WS_OCAT) + (size_t)tok * DM + 512 + ch) = o; }
      } }
    __syncthreads();
}

__device__ __forceinline__ void conv_unit(const Frame& F, int l, int unit) {
    const int c = F.tid, lane = F.lane, w = F.wave;
    const bool samp = unit >= 256; const int b = samp ? unit - 256 : unit >> 5, t0 = samp ? 0 : (unit & 31) * 64, nsub = samp ? 1 : 4;
    const int tokbase = samp ? NPR + b * ST : b * SEQ;
    const bf16_t* PJ = WSP(bf16_t, WS_PROJ) + CV_OFF;
    LAS float* ybuf = (LAS float*)F.lds;
    LAS float* stats = (LAS float*)(F.lds + 32768);
    float dw[31];
#pragma unroll
    for (int k = 0; k < 31; ++k) dw[k] = F.in[26][((size_t)l * 31 + k) * 512 + c];
    const float bias = F.in[27][l * 512 + c], lw = F.in[28][l * 512 + c], lb = F.in[29][l * 512 + c];
    float win[46];
    asm volatile("s_waitcnt vmcnt(0)" ::: "memory");
    if (samp) {
#pragma unroll
        for (int j = 0; j < 30; ++j) win[j] = F.in[4][(((size_t)l * SB + b) * 30 + j) * 512 + c];
    } else if (t0 > 0) {
#pragma unroll
        for (int hb = 0; hb < 2; ++hb) { bf16_t hv[15], hg[15];
#pragma unroll
            for (int j = 0; j < 15; ++j) { const bf16_t* pr = PJ + (size_t)(tokbase + t0 - 30 + 15 * hb + j) * NPJ; hv[j] = pr[c]; hg[j] = pr[512 + c]; }
            __builtin_amdgcn_sched_barrier(0);
#pragma unroll
            for (int j = 0; j < 15; ++j) win[15 * hb + j] = bf1(hv[j]) * sigm(bf1(hg[j]));
            __builtin_amdgcn_sched_barrier(0); }
    } else {
#pragma unroll
        for (int j = 0; j < 30; ++j) win[j] = 0.f;
    }
    __builtin_amdgcn_sched_barrier(0);
    bf16_t zv[16], zg[16];
#pragma unroll
    for (int i = 0; i < 16; ++i) { const bf16_t* pr = PJ + (size_t)(tokbase + t0 + i) * NPJ; zv[i] = pr[c]; zg[i] = pr[512 + c]; }
    __builtin_amdgcn_sched_barrier(0);
    for (int sub = 0; sub < nsub; ++sub) {
        const int tb = tokbase + t0 + sub * 16;
        asm volatile("s_waitcnt vmcnt(0)" ::: "memory");
#pragma unroll
        for (int i = 0; i < 16; ++i) win[30 + i] = bf1(zv[i]) * sigm(bf1(zg[i]));
        __builtin_amdgcn_sched_barrier(0);
        if (sub + 1 < nsub) {
#pragma unroll
            for (int i = 0; i < 16; ++i) { const bf16_t* pr = PJ + (size_t)(tb + 16 + i) * NPJ; zv[i] = pr[c]; zg[i] = pr[512 + c]; } }
        __builtin_amdgcn_sched_barrier(0);
        float y[16];
#pragma unroll
        for (int i = 0; i < 16; ++i) { float a = bias;
#pragma unroll
            for (int k = 0; k < 31; ++k) a += win[i + k] * dw[k];
            y[i] = a; ybuf[i * 512 + c] = a; }
        if (samp || (t0 == SEQ - 64 && sub == 3)) { float* so = F.out + (samp ? O_SCV : O_PCV) + ((size_t)l * 8 + b) * 30 * 512 + c;
#pragma unroll
            for (int j = 0; j < 30; ++j) so[(size_t)j * 512] = win[16 + j]; }
        __syncthreads();
#pragma unroll
        for (int r = 0; r < 2; ++r) { const int i = 2 * w + r; float v[8]; float s = 0.f;
#pragma unroll
            for (int e = 0; e < 8; ++e) { v[e] = ybuf[i * 512 + e * 64 + lane]; s += v[e]; }
            const float mean = wave_sum(s) * (1.0f / 512.0f); float q = 0.f;
#pragma unroll
            for (int e = 0; e < 8; ++e) { const float d = v[e] - mean; q += d * d; }
            const float rstd = __builtin_amdgcn_rsqf(wave_sum(q) * (1.0f / 512.0f) + 1e-5f);
            if (lane == 0) { stats[2 * i] = mean; stats[2 * i + 1] = rstd; } }
        __syncthreads();
#pragma unroll
        for (int i = 0; i < 16; ++i) { const float o = (y[i] - stats[2 * i]) * stats[2 * i + 1] * lw + lb; const float sv = o * sigm(o);
            WSP(bf16_t, WS_OCAT)[(size_t)(tb + i) * DM + 1024 + c] = (bf16_t)(pk2(sv, 0.f) & 0xffffu); }
        __syncthreads();
#pragma unroll
        for (int j = 0; j < 30; ++j) win[j] = win[j + 16];
    }
}

constexpr int AV_PITCH = 144;
__device__ __forceinline__ void attn_ldk(bf16x8 (&kf)[8], const bf16_t* kA, size_t strideA, const bf16_t* kB, size_t strideB, int split, int bc, int g_hi, int c16, int qd) {
#pragma unroll
    for (int kt = 0; kt < 4; ++kt) { int g = bc * 4 + kt; g = g < g_hi ? g : g_hi - 1;
        const bf16_t* kr = g < split ? kA + (size_t)(16 * g + c16) * strideA : kB + (size_t)(16 * (g - split) + c16) * strideB;
        kf[2 * kt] = *(const bf16x8*)(kr + 8 * qd); kf[2 * kt + 1] = *(const bf16x8*)(kr + 32 + 8 * qd); }
}
__device__ __forceinline__ void attn_wave_unit(const Frame& F, const bf16_t* qrowA  , const bf16_t* qrowB, const bf16_t* kA, size_t strideA, const bf16_t* kB, size_t strideB, int split,
                                               int g_lo, int g_hi, int qiA  , int qiB, const LAS float* table  , LAS unsigned char* vimg, int vrow0, bf16_t* orowA, bf16_t* orowB) {
    asm volatile("s_waitcnt vmcnt(0)" ::: "memory");
    const int lane = F.lane, c16 = lane & 15, qd = lane >> 4;
    bf16x8 q0[2], q1[2];
    q0[0] = *(const bf16x8*)(qrowA + 8 * qd); q1[0] = *(const bf16x8*)(qrowA + 32 + 8 * qd); q0[1] = *(const bf16x8*)(qrowB + 8 * qd); q1[1] = *(const bf16x8*)(qrowB + 32 + 8 * qd);
    const int qi[2] = {qiA, qiB};
    float mx[2] = {-1e30f, -1e30f}, sum[2] = {0.f, 0.f};
    const float tconst = table[256];
    f32x4 o[2][4];
#pragma unroll
    for (int t = 0; t < 2; ++t)
#pragma unroll
        for (int dt = 0; dt < 4; ++dt) o[t][dt] = (f32x4){0.f, 0.f, 0.f, 0.f};
    bf16x8 kf[8];
    attn_ldk(kf, kA, strideA, kB, strideB, split, g_lo >> 2, g_hi, c16, qd);
    for (int bc = g_lo >> 2; bc < 9; ++bc) {
        bf16x8 kn[8];
        attn_ldk(kn, kA, strideA, kB, strideB, split, bc + 1 < 9 ? bc + 1 : bc, g_hi, c16, qd);
        f32x4 s[2][4]; float cm[2] = {-1e30f, -1e30f};
#pragma unroll
        for (int kt = 0; kt < 4; ++kt) { const int g = bc * 4 + kt;
#pragma unroll
            for (int t = 0; t < 2; ++t) {
                f32x4 a = (f32x4){0.f, 0.f, 0.f, 0.f};
                a = __builtin_amdgcn_mfma_f32_16x16x32_bf16(kf[2 * kt], q0[t], a, 0, 0, 0); a = __builtin_amdgcn_mfma_f32_16x16x32_bf16(kf[2 * kt + 1], q1[t], a, 0, 0, 0);
#pragma unroll
                for (int e = 0; e < 4; ++e) { float bias = tconst; if (bc >= 6) { const int rel = 512 + qi[t] - (16 * g + 4 * qd + e); bias = table[(rel > 128 ? 128 : rel) + 128]; }
                    a[e] = g < g_hi ? a[e] * (0.125f * 1.44269504089f) + bias : -1e30f; cm[t] = fmaxf(cm[t], a[e]); }
                s[t][kt] = a; }
        }
#pragma unroll
        for (int t = 0; t < 2; ++t) {
            float c = cm[t]; c = fmaxf(c, __shfl_xor(c, 16)); c = fmaxf(c, __shfl_xor(c, 32));
            const float mn = fmaxf(mx[t], c), alpha = __builtin_amdgcn_exp2f(mx[t] - mn); mx[t] = mn; sum[t] *= alpha;
#pragma unroll
            for (int dt = 0; dt < 4; ++dt) o[t][dt] *= alpha; }
#pragma unroll
        for (int pp = 0; pp < 2; ++pp) {
            bf16x8 pf[2];
#pragma unroll
            for (int t = 0; t < 2; ++t) { float p[8];
#pragma unroll
                for (int e = 0; e < 4; ++e) { p[e] = __builtin_amdgcn_exp2f(s[t][2 * pp][e] - mx[t]); p[4 + e] = __builtin_amdgcn_exp2f(s[t][2 * pp + 1][e] - mx[t]); sum[t] += p[e] + p[4 + e]; }
                pf[t] = pack_frag(p); }
            LAS unsigned char* a = vimg + (vrow0 + 64 * bc + 32 * pp + 4 * qd + (c16 >> 2)) * AV_PITCH + 8 * (c16 & 3);
#pragma unroll
            for (int dt = 0; dt < 4; ++dt) { const bf16x8 vf = cat8(lds_tr(a + dt * 32), lds_tr(a + 16 * AV_PITCH + dt * 32));
                o[0][dt] = __builtin_amdgcn_mfma_f32_16x16x32_bf16(vf, pf[0], o[0][dt], 0, 0, 0); o[1][dt] = __builtin_amdgcn_mfma_f32_16x16x32_bf16(vf, pf[1], o[1][dt], 0, 0, 0); }
        }
#pragma unroll
        for (int i = 0; i < 8; ++i) kf[i] = kn[i];
    }
#pragma unroll
    for (int t = 0; t < 2; ++t) { float sm = sum[t]; sm += __shfl_xor(sm, 16); sm += __shfl_xor(sm, 32);
        const float inv = frcp(sm); bf16_t* orow = t == 0 ? orowA : orowB;
#pragma unroll
        for (int dt = 0; dt < 4; ++dt) { u32x2 wv; wv.x = pk2(o[t][dt][0] * inv, o[t][dt][1] * inv); wv.y = pk2(o[t][dt][2] * inv, o[t][dt][3] * inv); *(u32x2*)(orow + 16 * dt + 4 * qd) = wv; } }
}
constexpr int ATBL_OFF = 1024 * AV_PITCH;
__device__ __forceinline__ void attn_jobs(const Frame& F, int l) {
    const int lane = F.lane, w = F.wave, c16 = lane & 15;
    const bf16_t* PJ = WSP(bf16_t, WS_PROJ) + AT_OFF; bf16_t* OC = WSP(bf16_t, WS_OCAT) + 1536;
    LAS unsigned char* vimg = F.lds; LAS float* tbl = (LAS float*)(F.lds + ATBL_OFF);
    for (int slot = 0; slot < 2; ++slot) {
        const bool prompt = slot == 0; const int job = prompt ? F.c : F.G - 1 - F.c;
        if (job >= (prompt ? 256 : 64)) continue;
        const int b = prompt ? job >> 5 : job >> 3, h = prompt ? (job >> 2) & 7 : job & 7, seg = job & 3;
        if (F.tid < 257) tbl[F.tid] = F.in[30][((size_t)l * 8 + h) * 257 + F.tid] * 1.44269504089f;
        const bf16_t* CK = WSP(bf16_t, WS_CK) + ((size_t)l * SB + b) * 512 * 512 + h * 64; const bf16_t* CV = WSP(bf16_t, WS_CVV) + ((size_t)l * SB + b) * 512 * 512 + h * 64;
        if (prompt) {
            for (int it = 0; it < 16; it += 8) { u32x4 v[8];
#pragma unroll
                for (int j = 0; j < 8; ++j) { const int pc = F.tid + (it + j) * NTHR, row = pc >> 3, part = pc & 7, pos = (8 * seg - 8) * 64 + row;
                    v[j] = *(const u32x4*)(PJ + (size_t)(b * SEQ + (pos < 0 ? 0 : pos)) * NPJ + 1024 + h * 64 + part * 8); }
                __builtin_amdgcn_sched_barrier(0);
#pragma unroll
                for (int j = 0; j < 8; ++j) { const int pc = F.tid + (it + j) * NTHR, row = pc >> 3, part = pc & 7; *(LAS u32x4*)(vimg + row * AV_PITCH + part * 16) = v[j]; }
                __builtin_amdgcn_sched_barrier(0); }
        } else {
            u32x4 v[9];
#pragma unroll
            for (int j = 0; j < 9; ++j) { const int pc = F.tid + j * NTHR, row = pc >> 3, part = pc & 7;
                const bf16_t* src = row < 512 ? CV + (size_t)row * 512 + part * 8 : PJ + (size_t)(NPR + b * ST + (row < 528 ? row - 512 : 0)) * NPJ + 1024 + h * 64 + part * 8;
                v[j] = *(const u32x4*)src; if (row >= 528) v[j] = (u32x4){0u, 0u, 0u, 0u}; }
            __builtin_amdgcn_sched_barrier(0);
#pragma unroll
            for (int j = 0; j < 9; ++j) { const int pc = F.tid + j * NTHR, row = pc >> 3, part = pc & 7; *(LAS u32x4*)(vimg + row * AV_PITCH + part * 16) = v[j]; }
            __builtin_amdgcn_sched_barrier(0);
        }
        __syncthreads();
        const int nr = prompt ? 2 : 1;
        for (int r = 0; r < nr; ++r) {
            if (prompt || w == 0) {
                const int id = r * 8 + w, qc = id >> 1, qtA = 2 * (id & 1), qtB = prompt ? qtA + 1 : qtA, chunk = 8 * seg + qc;
                const int qtokA = prompt ? b * SEQ + chunk * 64 + qtA * 16 + c16 : NPR + b * ST + c16, qtokB = prompt ? qtokA + 16 : qtokA;
                const int pos0 = chunk * 64 - 512;
                const bf16_t* kA = prompt ? PJ + (ptrdiff_t)(b * SEQ + pos0) * NPJ + 512 + h * 64 : CK;
                const bf16_t* kB = PJ + (size_t)(NPR + b * ST) * NPJ + 512 + h * 64;
                attn_wave_unit(F, PJ + (size_t)qtokA * NPJ + h * 64, PJ + (size_t)qtokB * NPJ + h * 64, kA, prompt ? (size_t)NPJ : (size_t)512, kB, NPJ, prompt ? 36 : 32, prompt ? (pos0 < 0 ? (-pos0) / 16 : 0) : 0, prompt ? 36 : 33,
                               prompt ? qtA * 16 + c16 : c16, prompt ? qtB * 16 + c16 : c16, tbl, vimg, prompt ? qc * 64 : 0, OC + (size_t)qtokA * DM + h * 64, OC + (size_t)qtokB * DM + h * 64);
            }
        }
        __syncthreads();
    }
}

__device__ __forceinline__ void state_copies(const Frame& F, int l) {
    const size_t gt = (size_t)F.c * NTHR + F.tid, gs = (size_t)F.G * NTHR;
    const bf16_t* PJ = WSP(bf16_t, WS_PROJ);
    for (size_t i = gt; i < 16 * 248; i += gs) { const int s = (int)(i / 248), c8 = (int)(i % 248) * 8; const int tok = s < 8 ? s * SEQ + SEQ - 1 : NPR + (s - 8) * ST + ST - 1;
        float f[8]; unpack8(*(const u32x4*)(PJ + (size_t)tok * NPJ + c8), f); float* o = F.out + (s < 8 ? O_PSH : O_SSH) + ((size_t)l * 8 + (s & 7)) * RC + c8;
        *(f32x4*)o = (f32x4){f[0], f[1], f[2], f[3]}; *(f32x4*)(o + 4) = (f32x4){f[4], f[5], f[6], f[7]}; }
    for (size_t i = gt; i < (size_t)8 * 512 * 128; i += gs) { const int c8 = (int)(i & 127) * 8, r = (int)((i >> 7) & 511), b = (int)(i >> 16); const int tok = b * SEQ + SEQ - 512 + r;
        float f[8]; unpack8(*(const u32x4*)(PJ + (size_t)tok * NPJ + AT_OFF + 512 + c8), f);
        float* o = F.out + (c8 < 512 ? O_PK : O_PV) + (((size_t)l * NB + b) * 512 + r) * 512 + (c8 & 511);
        *(f32x4*)o = (f32x4){f[0], f[1], f[2], f[3]}; *(f32x4*)(o + 4) = (f32x4){f[4], f[5], f[6], f[7]}; }
    for (size_t i = gt; i < (size_t)NSA * 128; i += gs) { const int c8 = (int)(i & 127) * 8, r = (int)(i >> 7); const int tok = NPR + r;
        float f[8]; unpack8(*(const u32x4*)(PJ + (size_t)tok * NPJ + AT_OFF + 512 + c8), f);
        float* o = F.out + (c8 < 512 ? O_SK : O_SV) + ((size_t)l * NSA + r) * 512 + (c8 & 511);
        *(f32x4*)o = (f32x4){f[0], f[1], f[2], f[3]}; *(f32x4*)(o + 4) = (f32x4){f[4], f[5], f[6], f[7]}; }
}

__device__ __forceinline__ void ph_mixers(const Frame& F, int l) {
    REP(12) attn_jobs(F, l);
    REP(14) for (int u = F.c; u < 256 + 8; u += F.G) conv_unit(F, l, u);
    REP(15) { const int si = F.gw - 100 * NWAVE;
              for (int k = 0; k < 2; ++k) { int tt = -1, lo = 0, n = 0;
                  if (k == 0) { if (F.gw < (NPR / 16) * 2) { tt = F.gw >> 1; lo = 4 * (F.gw & 1); n = 4; } } else if (si >= 0 && si < 64) { tt = NPR / 16 + (si >> 3); lo = si & 7; n = 1; }
                  if (tt >= 0) rwkv_prep_unit(F, l, tt, lo, n); }
              for (int k = 0; k < 2; ++k) { int tt = -1, lo = 0, n = 0;
                  if (k == 0) { if (F.gw < (NPR / 16) * 2) { tt = F.gw >> 1; lo = 16 * (F.gw & 1); n = 16; } } else if (si >= 64 && si < 128) { tt = NPR / 16 + ((si - 64) >> 3); lo = 4 * (si & 7); n = 4; }
                  if (tt >= 0) rwkv_gate_unit(F, l, tt, lo, n); } }
    REP(16) state_copies(F, l);
}

constexpr int SG = 5;
__device__ __forceinline__ void scan_block(const Frame& F, int tokbase, int nchunk, int h, const float* S0, float* Sout, float* Y) {
    const int lane = F.lane, w = F.wave, fr = lane & 15, fq = lane >> 4, rt = w & 3, row = 16 * rt + fr;
    const bool cons = w < 4;
#define SCAN_BAR() do { asm volatile("" ::: "memory"); __builtin_amdgcn_s_barrier(); asm volatile("" ::: "memory"); } while (0)
    f32x4 ST[4];
#pragma unroll
    for (int kt = 0; kt < 4; ++kt) ST[kt] = (cons && S0) ? *(const f32x4*)(S0 + row * 64 + 16 * kt + 4 * fq) : (f32x4){0.f, 0.f, 0.f, 0.f};
    const unsigned char* rec0 = F.ws + WS_REC + ((size_t)(tokbase / 16) * 8 + h) * REC_BYTES;
    const int ngroup = (nchunk + SG - 1) / SG;
#define SCAN_FILL(g_) do { const int g0_ = (g_) * SG, nck_ = nchunk - g0_ < SG ? nchunk - g0_ : SG; \
        for (int p_ = w - 4; p_ < nck_ * 14; p_ += 4) { const int ci_ = p_ / 14, pi_ = p_ - 14 * ci_; \
            __builtin_amdgcn_global_load_lds((const unsigned*)(rec0 + (size_t)(g0_ + ci_) * 8 * REC_BYTES + pi_ * 1024 + lane * 16), (LAS unsigned*)(F.lds + ((g_) & 1) * (SG * REC_BYTES) + ci_ * REC_BYTES + pi_ * 1024), 16, 0, 0); } } while (0)
    if (!cons) { SCAN_FILL(0); asm volatile("s_waitcnt vmcnt(0)" ::: "memory"); }
    SCAN_BAR();
    for (int g = 0; g < ngroup; ++g) {
        if (!cons) { if (g + 1 < ngroup) SCAN_FILL(g + 1); asm volatile("s_waitcnt vmcnt(0)" ::: "memory"); }
        else {
            const int g0 = g * SG, nck = nchunk - g0 < SG ? nchunk - g0 : SG;
            for (int ci = 0; ci < nck; ++ci) {
                LAS unsigned char* base = F.lds + (g & 1) * (SG * REC_BYTES) + ci * REC_BYTES;
                bf16x8 f[11];
#pragma unroll
                for (int i = 0; i < 11; ++i) f[i] = *(const LAS bf16x8*)(base + i * 1024 + lane * 16);
                const u32x2 fv = *(const LAS u32x2*)(base + REC_FV + rt * 512 + lane * 8);
                f32x4 gg[4];
#pragma unroll
                for (int kt = 0; kt < 4; ++kt) gg[kt] = *(const LAS f32x4*)(base + REC_G16 + (16 * kt + 4 * fq) * 4);
                bf16x8 sb[2];
#pragma unroll
                for (int ks = 0; ks < 2; ++ks) { const float x[8] = {ST[2 * ks][0], ST[2 * ks][1], ST[2 * ks][2], ST[2 * ks][3], ST[2 * ks + 1][0], ST[2 * ks + 1][1], ST[2 * ks + 1][2], ST[2 * ks + 1][3]}; sb[ks] = pack_frag(x); }
                const bf16x8 vB = __builtin_bit_cast(bf16x8, (u32x4){fv.x, fv.y, 0u, 0u});
                f32x4 aP = (f32x4){0.f, 0.f, 0.f, 0.f};
                aP = __builtin_amdgcn_mfma_f32_16x16x32_bf16(f[0], sb[0], aP, 0, 0, 0); aP = __builtin_amdgcn_mfma_f32_16x16x32_bf16(f[1], sb[1], aP, 0, 0, 0); aP = __builtin_amdgcn_mfma_f32_16x16x32_bf16(f[4], vB, aP, 0, 0, 0);
                const bf16x8 pB = __builtin_bit_cast(bf16x8, (u32x4){pk2(aP[0], aP[1]), pk2(aP[2], aP[3]), 0u, 0u});
                f32x4 aU = (f32x4){0.f, 0.f, 0.f, 0.f};
                aU = __builtin_amdgcn_mfma_f32_16x16x32_bf16(f[5], pB, aU, 0, 0, 0);
                const bf16x8 uvB = __builtin_bit_cast(bf16x8, (u32x4){pk2(aU[0], aU[1]), pk2(aU[2], aU[3]), fv.x, fv.y});
                f32x4 aY = (f32x4){0.f, 0.f, 0.f, 0.f};
                aY = __builtin_amdgcn_mfma_f32_16x16x32_bf16(f[2], sb[0], aY, 0, 0, 0); aY = __builtin_amdgcn_mfma_f32_16x16x32_bf16(f[3], sb[1], aY, 0, 0, 0); aY = __builtin_amdgcn_mfma_f32_16x16x32_bf16(f[6], uvB, aY, 0, 0, 0);
                float* yp = Y + (size_t)(tokbase + 16 * (g0 + ci) + 4 * fq) * 512 + h * 64 + row;
#pragma unroll
                for (int j = 0; j < 4; ++j) yp[(size_t)j * 512] = aY[j];
#pragma unroll
                for (int kt = 0; kt < 4; ++kt) { ST[kt] = __builtin_amdgcn_mfma_f32_16x16x32_bf16(f[7 + kt], uvB, ST[kt], 0, 0, 0); ST[kt] *= gg[kt]; }
            }
        }
        SCAN_BAR();
    }
    if (cons) {
#pragma unroll
        for (int kt = 0; kt < 4; ++kt) *(f32x4*)(Sout + row * 64 + 16 * kt + 4 * fq) = ST[kt]; }
#undef SCAN_FILL
#undef SCAN_BAR
}
__device__ __forceinline__ void ph_scan(const Frame& F, int l) {
    float* Y = WSP(float, WS_Y);
    for (int item = F.c; item < 128; item += F.G) {
        const bool pr = item < 64; const int bh = item & 63, b = bh >> 3, h = bh & 7;
        const size_t so = (((size_t)l * 8 + b) * 8 + h) * 4096;
        scan_block(F, pr ? b * SEQ : NPR + b * ST, pr ? SEQ / 16 : 1, h, pr ? nullptr : F.in[3] + so, F.out + (pr ? O_PWKV : O_SWKV) + so, Y);
    }
}

__device__ __forceinline__ void ph_finish(const Frame& F, int l) {
    const float* Y = WSP(float, WS_Y); const bf16_t* V = (const bf16_t*)(WSP(float, WS_SCAN) + 3 * (size_t)MR * 512); const bf16_t* GG = WSP(bf16_t, WS_G);     const float* BON = WSP(float, WS_BON);
    const float* gnw = F.in[20] + l * 512; const float* gnb = F.in[21] + l * 512;
    const int l16 = F.lane & 15, sub = F.lane >> 4;
    for (int it = F.gw; it < MR * 8 / 4; it += F.G * NWAVE) {
        const int idx = it * 4 + sub, tok = idx >> 3, hd = idx & 7, col = hd * 64 + 4 * l16;
        const f32x4 y = *(const f32x4*)(Y + (size_t)tok * 512 + col);
        const float mean = row16_sum(y[0] + y[1] + y[2] + y[3]) * (1.0f / 64.0f);
        const f32x4 d = y - mean;
        const float var = row16_sum(d[0] * d[0] + d[1] * d[1] + d[2] * d[2] + d[3] * d[3]) * (1.0f / 64.0f);
        const float rstd = __builtin_amdgcn_rsqf(var + 64e-5f);
        const f32x4 gw4 = *(const f32x4*)(gnw + col), gb4 = *(const f32x4*)(gnb + col), v4 = ({ const u32x2 t_ = *(const u32x2*)(V + (size_t)tok * 512 + col); (f32x4){bflo(t_.x), bfhi(t_.x), bflo(t_.y), bfhi(t_.y)}; }), g4 = ({ const u32x2 t_ = *(const u32x2*)(GG + (size_t)tok * 512 + col); (f32x4){bflo(t_.x), bfhi(t_.x), bflo(t_.y), bfhi(t_.y)}; });
        const float bon = BON[(size_t)tok * 8 + hd];
        const f32x4 o = (d * rstd * gw4 + gb4 + bon * v4) * g4;
        u32x2 w; w.x = pk2(o[0], o[1]); w.y = pk2(o[2], o[3]);
        *(u32x2*)(WSP(bf16_t, WS_OCAT) + (size_t)tok * DM + col) = w;
    }
}

template <bool DUAL, int STEPS>
__device__ __forceinline__ void skinny_trip(const bf16_t* __restrict__ wrow, const bf16_t* __restrict__ arow, const int K, const int ks, f32x4 (&acc)[4], f32x4 (&acc2)[4]) {
    bf16x8 wf[STEPS], wf2[STEPS], af[STEPS][4];
#pragma unroll
    for (int u = 0; u < STEPS; ++u) { wf[u] = *(const bf16x8*)(wrow + 32 * (ks + u)); if (DUAL) wf2[u] = *(const bf16x8*)(wrow + (size_t)128 * K + 32 * (ks + u));
#pragma unroll
        for (int rt = 0; rt < 4; ++rt) af[u][rt] = *(const bf16x8*)(arow + (size_t)rt * 16 * K + 32 * (ks + u)); }
    __builtin_amdgcn_sched_barrier(0);
#pragma unroll
    for (int u = 0; u < STEPS; ++u)
#pragma unroll
        for (int rt = 0; rt < 4; ++rt) { acc[rt] = __builtin_amdgcn_mfma_f32_16x16x32_bf16(wf[u], af[u][rt], acc[rt], 0, 0, 0);
            if (DUAL) acc2[rt] = __builtin_amdgcn_mfma_f32_16x16x32_bf16(wf2[u], af[u][rt], acc2[rt], 0, 0, 0); }
    __builtin_amdgcn_sched_barrier(0);
}
__device__ __forceinline__ void skinny_gemm(const Frame& F, const int MODE, const bf16_t* __restrict__ A, const bf16_t* __restrict__ Wt, const int K, const int nslices) {
    const int lane = F.lane, w = F.wave, c16 = lane & 15, qd = lane >> 4;
    LAS f32x4* red = (LAS f32x4*)F.lds;
    const int kw = K / 8, nks = kw / 32;
    for (int item = F.c; item < 2 * nslices; item += F.G) {
        const int sl = item >> 1, rh = item & 1, n0 = sl * 16;
        const bf16_t* wrow = Wt + (size_t)(MODE == 2 ? 256 * (n0 >> 7) + (n0 & 127) + c16 : n0 + c16) * K + w * kw + 8 * qd;
        const bf16_t* arow = A + (size_t)(NPR + rh * 64 + c16) * K + w * kw + 8 * qd;
        f32x4 acc[4], acc2[4];
#pragma unroll
        for (int rt = 0; rt < 4; ++rt) { acc[rt] = (f32x4){0.f, 0.f, 0.f, 0.f}; acc2[rt] = acc[rt]; }
        int ks = 0;
        if (MODE == 2) { for (; ks + 4 <= nks; ks += 4) skinny_trip<true, 4>(wrow, arow, K, ks, acc, acc2); }
        else { for (; ks + 4 <= nks; ks += 4) skinny_trip<false, 4>(wrow, arow, K, ks, acc, acc2); if (ks < nks) skinny_trip<false, 2>(wrow, arow, K, ks, acc, acc2); }
#pragma unroll
        for (int rt = 0; rt < 4; ++rt) { red[(w * 4 + rt) * 64 + lane] = acc[rt]; if (MODE == 2) red[2048 + (w * 4 + rt) * 64 + lane] = acc2[rt]; }
        __syncthreads();
        if (w < 4) { const int rt = w, tok = NPR + rh * 64 + rt * 16 + c16, n = n0 + 4 * qd;
          if (MODE == 0) { f32x4 sum = (f32x4){0.f, 0.f, 0.f, 0.f};
#pragma unroll
              for (int ww = 0; ww < 8; ++ww) sum += red[(ww * 4 + rt) * 64 + lane];
              bf16_t* xp = WSP(bf16_t, WS_X) + (size_t)tok * DM + n; const u32x2 xo = *(const u32x2*)xp;
              u32x2 o; o.x = pk2(bflo(xo.x) + sum[0], bfhi(xo.x) + sum[1]); o.y = pk2(bflo(xo.y) + sum[2], bfhi(xo.y) + sum[3]); *(u32x2*)xp = o; }
          if (MODE == 1) { f32x4 tot = (f32x4){0.f, 0.f, 0.f, 0.f}; const bf16_t* gp0 = WSP(bf16_t, WS_PROJ) + (size_t)tok * NPJ + GT_OFF;
#pragma unroll
              for (int b = 0; b < 4; ++b) { const f32x4 sb = red[((2 * b) * 4 + rt) * 64 + lane] + red[((2 * b + 1) * 4 + rt) * 64 + lane]; const unsigned gw = *(const unsigned*)((const unsigned char*)gp0 + b * DM + n);
                  tot += sb * ((f32x4){(float)((gw >> 0) & 0xffu), (float)((gw >> 8) & 0xffu), (float)((gw >> 16) & 0xffu), (float)((gw >> 24) & 0xffu)} * (1.0f / 255.0f)); }
              u32x2 o; o.x = pk2(tot[0], tot[1]); o.y = pk2(tot[2], tot[3]); *(u32x2*)(WSP(bf16_t, WS_MRG) + (size_t)tok * DM + n) = o; }
          if (MODE == 2) { f32x4 sg = (f32x4){0.f, 0.f, 0.f, 0.f}, su = sg;
#pragma unroll
              for (int ww = 0; ww < 8; ++ww) { sg += red[(ww * 4 + rt) * 64 + lane]; su += red[2048 + (ww * 4 + rt) * 64 + lane]; }
              u32x2 o; o.x = pk2(sg[0] * sigm(sg[0]) * su[0], sg[1] * sigm(sg[1]) * su[1]); o.y = pk2(sg[2] * sigm(sg[2]) * su[2], sg[3] * sigm(sg[3]) * su[3]);
              *(u32x2*)(WSP(bf16_t, WS_PROJ) + (size_t)tok * DFF + n) = o; } }
        __syncthreads();
    }
}

__global__ void __launch_bounds__(NTHR, 2) mega(Params P) {
    extern __shared__ __attribute__((aligned(16))) unsigned char lds_raw[];
    Frame F;
    F.lds = (LAS unsigned char*)lds_raw; F.tid = threadIdx.x; F.lane = F.tid & 63; F.wave = __builtin_amdgcn_readfirstlane(F.tid >> 6);
    F.G = gridDim.x; F.c = blockIdx.x; F.gw = F.c * NWAVE + F.wave; F.in = P.in; F.out = P.out; F.ws = P.ws;
    const int lo = P.lo, hi = P.hi;
    const int wave0_ = __builtin_amdgcn_readfirstlane(threadIdx.x >> 6);
#define REFRAME() do { int t_ = wave0_ * 64 + (int)__builtin_amdgcn_mbcnt_hi(~0u, __builtin_amdgcn_mbcnt_lo(~0u, 0u)), c_ = blockIdx.x; asm volatile("" : "+v"(t_)); asm volatile("" : "+s"(c_)); F.tid = t_; F.lane = t_ & 63; F.wave = __builtin_amdgcn_readfirstlane(t_ >> 6); \
        F.c = c_; F.gw = c_ * NWAVE + F.wave; } while (0)
    XcdBarrier bar; bar.bar = (unsigned*)(P.ws + WS_CTL); bar.x = 0; bar.st = (volatile LAS unsigned*)(F.lds + LDS_BAR_OFF);
    if (hi - lo > 1) {
        if (F.tid == 0) { bar.st[0] = 0u; bar.st[1] = 0u; bar.st[2] = 0u; bar.st[3] = 0u; }
        __syncthreads();
        bar = xcd_barrier_post((unsigned*)(P.ws + WS_CTL), (volatile LAS unsigned*)(F.lds + LDS_BAR_OFF));
    }
    int ph = 0;
#define PHASE_BEGIN if (ph >= lo && ph < hi) { REFRAME();
#define PHASE_END   if (ph + 1 < hi) xcd_barrier(bar); } ++ph;
    PHASE_BEGIN REP(0) { ph_prep(F); __syncthreads(); ph_rmsnorm<false>(F, F.in[7], true); } PHASE_END
    for (int gi = 0; gi < NL * 5; ++gi) {
        const int l = gi / 5, k = gi - 5 * l;
        if ((k == 0 && gi != 0) || k == 3) { PHASE_BEGIN REP(1) ph_rmsnorm<false>(F, F.in[k == 0 ? 7 : 8] + l * DM, false); PHASE_END }
        if (k == 1) {
            PHASE_BEGIN ph_mixers(F, l); PHASE_END
            PHASE_BEGIN REP(4) { ph_scan(F, l); __syncthreads(); }
                        for (int u = (F.c + F.G - 64) % F.G; u < 128 + 8; u += F.G) gmlp_unit(F, l, u);
            PHASE_END
            PHASE_BEGIN REP(5) ph_finish(F, l); PHASE_END
        }
        PHASE_BEGIN REP(2) {
            const bf16_t* A = WSP(bf16_t, k == 0 || k == 3 ? WS_H : k == 1 ? WS_OCAT : k == 2 ? WS_MRG : WS_PROJ);
            const bf16_t* Bt = k == 0 ? WSP(bf16_t, WS_WIN) + (size_t)l * NPJ * DM : k == 1 ? WSP(bf16_t, WS_WBR) + (size_t)l * DM * DM : k == 2 ? WSP(bf16_t, WS_WOUT) + (size_t)l * DM * DM
                             : k == 3 ? WSP(bf16_t, WS_WFI) + (size_t)l * 2 * DFF * DM : WSP(bf16_t, WS_WFO) + (size_t)l * DM * DFF;
            const int M = k == 0 ? MP : NPR, N = k == 0 ? NPJ : k == 3 ? 2 * DFF : DM, K = k == 4 ? DFF : DM;
            pg8::Gemm g{A, Bt, M, N, K}; pg8::StaticOrder S; S.init(M, N, F.G, F.c);
            pg8::EpiAny E{k == 0 ? 0 : k == 1 ? 1 : k == 3 ? 3 : 2, k == 1 ? WSP(bf16_t, WS_MRG) : WSP(bf16_t, WS_PROJ), WSP(bf16_t, WS_PROJ) + GT_OFF, WSP(bf16_t, WS_X)};
            pg8::gemm_phase<pg8::EpiAny, pg8::StaticOrder>(F.lds, g, S, E, F.tid);
            if (k != 0) skinny_gemm(F, k == 1 ? 1 : k == 3 ? 2 : 0, A, Bt, K, k == 3 ? DFF / 16 : DM / 16);
        } PHASE_END
    }
    PHASE_BEGIN ph_rmsnorm<true>(F, F.in[9], false); PHASE_END
}
constexpr int NPHASE = 1 + NL * 10 + 1 - 1;

extern "C" void kernel_launch(void* const* d_in, const int* in_sizes, int n_in, void* d_out, int out_size, void* d_ws, size_t ws_size, hipStream_t stream) {
    static int grid = 0;
    if (grid == 0) {
        if (n_in != 35 || (size_t)out_size != O_END || ws_size < WS_END) { fprintf(stderr, "kernel_launch: unexpected shapes: n_in %d out %d (want %zu) ws %zu (want %zu)\n", n_in, out_size, (size_t)O_END, ws_size, (size_t)WS_END); grid = -1; return; }
        int dev = 0, cus = 0, per_cu = 0;
        if (hipGetDevice(&dev) != hipSuccess || hipDeviceGetAttribute(&cus, hipDeviceAttributeMultiprocessorCount, dev) != hipSuccess) { fprintf(stderr, "kernel_launch: device query failed\n"); grid = -1; return; }
        if (hipFuncSetAttribute((const void*)mega, hipFuncAttributeMaxDynamicSharedMemorySize, LDS_BYTES) != hipSuccess) { fprintf(stderr, "kernel_launch: hipFuncSetAttribute failed\n"); grid = -1; return; }
        if (hipOccupancyMaxActiveBlocksPerMultiprocessor(&per_cu, (const void*)mega, NTHR, LDS_BYTES) != hipSuccess || per_cu < 1) fprintf(stderr, "kernel_launch: occupancy query says %d\n", per_cu);
        (void)hipGetLastError();
        grid = cus;
    }
    if (grid < 0) return;
    (void)hipMemsetAsync((char*)d_ws + WS_CTL, 0, CTL_BYTES, stream);
    Params p{};
    for (int i = 0; i < 35; ++i) p.in[i] = (const float*)d_in[i];
    p.out = (float*)d_out; p.ws = (unsigned char*)d_ws;
#if ONE_LAUNCH
    p.lo = 0; p.hi = NPHASE;
    hipLaunchKernelGGL(mega, dim3(grid), dim3(NTHR), LDS_BYTES, stream, p);
#else
    for (int i = 0; i < NPHASE; ++i) { p.lo = i; p.hi = i + 1; hipLaunchKernelGGL(mega, dim3(grid), dim3(NTHR), LDS_BYTES, stream, p); }
#endif
    const hipError_t le = hipPeekAtLastError();
    if (le != hipSuccess) fprintf(stderr, "kernel_launch: launch failed: %s\n", hipGetErrorName(le));
}
```
